# Optimizing an MI355X kernel written in HIP

```python
import math
import jax, jax.numpy as jnp
from jax import lax
import numpy as np

D_MODEL = 1024
BATCH = 2
SEQ = 8192
DEPTH = 1

RWKV_HEAD_DIM = 64
RWKV_HEADS = D_MODEL // (2 * RWKV_HEAD_DIM)
RWKV_WIDTH = RWKV_HEADS * RWKV_HEAD_DIM
DECAY_LORA = 64
ICLR_LORA = 64
GATE_LORA = 128
GN_EPS = 64e-5
N_DIR = 2

DA_HEAD_DIM = 64
DA_HEADS = D_MODEL // (4 * DA_HEAD_DIM)
DA_V_DIM = 2 * DA_HEAD_DIM
DA_QK_WIDTH = DA_HEADS * 2 * DA_HEAD_DIM
DA_V_WIDTH = DA_HEADS * DA_V_DIM
SUBLN_EPS = 1e-5
Q_BLOCK = 128

ROPE_THETA = 500000.0
ROPE_DIM = DA_HEAD_DIM // 4

D_FF = 4 * D_MODEL
PLE_DIM = 256
N_BRANCH = 2
RMS_EPS = 1e-6

RWKV_COLS = 3 * RWKV_WIDTH + N_DIR * DECAY_LORA + N_DIR * ICLR_LORA + GATE_LORA
DA_COLS = 2 * DA_QK_WIDTH + DA_V_WIDTH
GATE_COLS = N_BRANCH * D_MODEL
IN_COLS = RWKV_COLS + DA_COLS + GATE_COLS

kernel_name = "hybrid_rwkv7_diffattn_gated_encoder"


def rmsnorm(x, g, eps=RMS_EPS):
    xf = x.astype(jnp.float32)
    y = xf * lax.rsqrt(jnp.mean(xf * xf, axis=-1, keepdims=True) + eps)
    return (y * g.astype(jnp.float32)).astype(x.dtype)


def centred_shift(u, mu_prev, mu_next):
    up = jnp.pad(u, ((0, 0), (1, 1), (0, 0)))
    return u + mu_prev * (up[:, :-2] - u) + mu_next * (up[:, 2:] - u)


def rwkv7_scan(r, w, k, v, kk, a, reverse):
    B, S, H, N = r.shape

    def step(state, inp):
        r_t, w_t, k_t, v_t, kk_t, a_t = inp
        sa = jnp.einsum('bhij,bhj->bhi', state, -kk_t)
        state = (state * w_t[:, :, None, :]
                 + sa[..., None] * (kk_t * a_t)[:, :, None, :]
                 + v_t[..., None] * k_t[:, :, None, :])
        y_t = jnp.einsum('bhij,bhj->bhi', state, r_t)
        return state, y_t

    xs = tuple(jnp.moveaxis(t, 1, 0) for t in (r, w, k, v, kk, a))
    s0 = jnp.zeros((B, H, N, N), jnp.float32)
    _, ys = lax.scan(step, s0, xs, reverse=reverse)
    return jnp.moveaxis(ys, 0, 1)


def rwkv7_branch(u, mu_prev, mu_next, w0, w2, a0, a2, g2, k_k, k_a, r_k, ln_w, ln_b, w_o):
    f32 = jnp.float32
    B, S, _ = u.shape
    H, N, W = RWKV_HEADS, RWKV_HEAD_DIM, RWKV_WIDTH
    u = centred_shift(u, mu_prev, mu_next).astype(f32)
    o1, o2, o3 = W, 2 * W, 3 * W
    o4 = o3 + N_DIR * DECAY_LORA
    o5 = o4 + N_DIR * ICLR_LORA
    r = u[..., :o1]
    k = u[..., o1:o2]
    v = u[..., o2:o3]
    wd = u[..., o3:o4].reshape(B, S, N_DIR, DECAY_LORA)
    ad = u[..., o4:o5].reshape(B, S, N_DIR, ICLR_LORA)
    gd = u[..., o5:]

    w_log = -jax.nn.softplus(-(w0.astype(f32) + jnp.einsum('bsdr,drc->bsdc', jnp.tanh(wd), w2.astype(f32)))) - 0.5
    decay = jnp.exp(-jnp.exp(w_log)).reshape(B, S, N_DIR, H, N)
    a = jax.nn.sigmoid(a0.astype(f32) + jnp.einsum('bsdr,drc->bsdc', ad, a2.astype(f32))).reshape(B, S, N_DIR, H, N)
    g = jax.nn.sigmoid(gd) @ g2.astype(f32)

    kk = (k * k_k.astype(f32)).reshape(B, S, H, N)
    kk = kk / jnp.maximum(jnp.sqrt(jnp.sum(kk * kk, axis=-1, keepdims=True)), 1e-12)
    r_h = r.reshape(B, S, H, N)
    v_h = v.reshape(B, S, H, N)
    k_dir = k.reshape(B, S, 1, H, N) * (1.0 + (a - 1.0) * k_a.astype(f32).reshape(H, N))

    y = (rwkv7_scan(r_h, decay[:, :, 0], k_dir[:, :, 0], v_h, kk, a[:, :, 0], False)
         + rwkv7_scan(r_h, decay[:, :, 1], k_dir[:, :, 1], v_h, kk, a[:, :, 1], True))

    mean = jnp.mean(y, axis=-1, keepdims=True)
    var = jnp.mean(jnp.square(y - mean), axis=-1, keepdims=True)
    y = ((y - mean) * lax.rsqrt(var + GN_EPS)).reshape(B, S, W)
    y = y * ln_w.astype(f32) + ln_b.astype(f32)
    bonus = jnp.sum(jnp.sum(r_h[:, :, None] * k_dir * r_k.astype(f32), axis=-1, keepdims=True), axis=2) * v_h
    y = (y + bonus.reshape(B, S, W)) * g
    return (y @ w_o.astype(f32)).astype(w_o.dtype)


def rope_tables(S):
    pos = jnp.arange(S, dtype=jnp.float32)
    inv_freq = ROPE_THETA ** (-jnp.arange(0, ROPE_DIM, 2, dtype=jnp.float32) / ROPE_DIM)
    ang = pos[:, None] * inv_freq[None, :]
    return jnp.cos(ang), jnp.sin(ang)


def partial_rope(x, cos, sin):
    half = ROPE_DIM // 2
    c = cos[:, None, None, :]
    s = sin[:, None, None, :]
    x1 = x[..., :half].astype(jnp.float32)
    x2 = x[..., half:ROPE_DIM].astype(jnp.float32)
    rot = jnp.concatenate([x1 * c - x2 * s, x2 * c + x1 * s], axis=-1)
    return jnp.concatenate([rot.astype(x.dtype), x[..., ROPE_DIM:]], axis=-1)


def diff_attn_branch(u, lq1, lk1, lq2, lk2, subln_w, w_o, lambda_init):
    f32 = jnp.float32
    B, S, _ = u.shape
    H, DH, DV = DA_HEADS, DA_HEAD_DIM, DA_V_DIM
    q = u[..., :DA_QK_WIDTH].reshape(B, S, H, 2, DH)
    k = u[..., DA_QK_WIDTH:2 * DA_QK_WIDTH].reshape(B, S, H, 2, DH)
    v = u[..., 2 * DA_QK_WIDTH:].reshape(B, S, H, DV)
    cos, sin = rope_tables(S)
    q = partial_rope(q, cos, sin) * (DH ** -0.5)
    k = partial_rope(k, cos, sin)
    lam = (jnp.exp(jnp.sum(lq1.astype(f32) * lk1.astype(f32)))
           - jnp.exp(jnp.sum(lq2.astype(f32) * lk2.astype(f32))) + lambda_init)

    kt = k.transpose(0, 2, 3, 1, 4)
    vt = v.transpose(0, 2, 1, 3)
    n_blk = S // Q_BLOCK
    qb = q.reshape(B, n_blk, Q_BLOCK, H, 2, DH).transpose(1, 0, 3, 4, 2, 5)

    def block(q_blk):
        s = jnp.einsum('bhcqd,bhckd->bhcqk', q_blk, kt).astype(f32)
        pr = jax.nn.softmax(s, axis=-1)
        pd = pr[:, :, 0] - lam * pr[:, :, 1]
        return jnp.einsum('bhqk,bhkv->bhqv', pd.astype(vt.dtype), vt)

    o = lax.map(block, qb)
    o = o.transpose(1, 0, 3, 2, 4).reshape(B, S, H, DV).astype(f32)
    o = o * lax.rsqrt(jnp.mean(o * o, axis=-1, keepdims=True) + SUBLN_EPS)
    o = o * subln_w.astype(f32) * (1.0 - lambda_init)
    return o.reshape(B, S, DA_V_WIDTH).astype(w_o.dtype) @ w_o


def setup_inputs(seed: int = 0) -> dict:
    key = jax.random.key(seed)
    ks = iter(jax.random.split(key, 40))
    L, D, W = DEPTH, D_MODEL, RWKV_WIDTH
    f32 = jnp.float32

    def nrm(shape, scale):
        return jax.random.normal(next(ks), shape, f32) * scale

    def gain(shape):
        return 1.0 + 0.05 * jax.random.normal(next(ks), shape, f32)

    def unif(shape, lo, hi):
        return jax.random.uniform(next(ks), shape, f32, lo, hi)

    return {
        "x": nrm((BATCH, SEQ, D), 1.0),
        "p": nrm((DEPTH, BATCH, SEQ, PLE_DIM), 1.0),
        "norm_mix": gain((L, D)),
        "w_in": nrm((L, D, IN_COLS), D ** -0.5),
        "shift_mu_prev": unif((L, RWKV_COLS), 0.0, 0.5),
        "shift_mu_next": unif((L, RWKV_COLS), 0.0, 0.5),
        "rwkv_w0": unif((L, N_DIR, W), -6.0, 1.0),
        "rwkv_w2": nrm((L, N_DIR, DECAY_LORA, W), 0.1 * DECAY_LORA ** -0.5),
        "rwkv_a0": nrm((L, N_DIR, W), 0.5),
        "rwkv_a2": nrm((L, N_DIR, ICLR_LORA, W), 0.1 * ICLR_LORA ** -0.5),
        "rwkv_g2": nrm((L, GATE_LORA, W), GATE_LORA ** -0.5),
        "rwkv_k_k": 0.85 + 0.05 * jax.random.normal(next(ks), (L, W), f32),
        "rwkv_k_a": gain((L, W)),
        "rwkv_r_k": nrm((L, RWKV_HEADS, RWKV_HEAD_DIM), 0.1),
        "rwkv_ln_w": gain((L, W)),
        "rwkv_ln_b": nrm((L, W), 0.01),
        "rwkv_w_o": nrm((L, W, D), W ** -0.5),
        "da_lq1": nrm((L, DA_HEAD_DIM), 0.1),
        "da_lk1": nrm((L, DA_HEAD_DIM), 0.1),
        "da_lq2": nrm((L, DA_HEAD_DIM), 0.1),
        "da_lk2": nrm((L, DA_HEAD_DIM), 0.1),
        "da_subln_w": gain((L, DA_V_DIM)),
        "da_w_o": nrm((L, DA_V_WIDTH, D), DA_V_WIDTH ** -0.5),
        "w_out": nrm((L, D, D), D ** -0.5),
        "norm_ffn": gain((L, D)),
        "w_ff1": nrm((L, D, D_FF), D ** -0.5),
        "w_ff2": nrm((L, D_FF, D), D_FF ** -0.5),
        "norm_ple": gain((L, D)),
        "w_ple_gate": nrm((L, D, D), D ** -0.5),
        "w_ple_proj": nrm((L, PLE_DIM, D), PLE_DIM ** -0.5),
        "norm_final": gain((D,)),
    }


def reference(x, p, norm_mix, w_in, shift_mu_prev, shift_mu_next, rwkv_w0, rwkv_w2, rwkv_a0,
              rwkv_a2, rwkv_g2, rwkv_k_k, rwkv_k_a, rwkv_r_k, rwkv_ln_w, rwkv_ln_b, rwkv_w_o,
              da_lq1, da_lk1, da_lq2, da_lk2, da_subln_w, da_w_o, w_out, norm_ffn, w_ff1, w_ff2,
              norm_ple, w_ple_gate, w_ple_proj, norm_final):
    B, S, D = x.shape
    for i in range(DEPTH):
        lambda_init = 0.8 - 0.6 * math.exp(-0.3 * i)
        h = rmsnorm(x, norm_mix[i])
        u = h @ w_in[i]
        u_rwkv = u[..., :RWKV_COLS]
        u_da = u[..., RWKV_COLS:RWKV_COLS + DA_COLS]
        gates = jax.nn.sigmoid(u[..., RWKV_COLS + DA_COLS:].astype(jnp.float32)).reshape(B, S, N_BRANCH, D)
        y_a = rwkv7_branch(u_rwkv, shift_mu_prev[i], shift_mu_next[i], rwkv_w0[i], rwkv_w2[i],
                           rwkv_a0[i], rwkv_a2[i], rwkv_g2[i], rwkv_k_k[i], rwkv_k_a[i], rwkv_r_k[i],
                           rwkv_ln_w[i], rwkv_ln_b[i], rwkv_w_o[i])
        y_b = diff_attn_branch(u_da, da_lq1[i], da_lk1[i], da_lq2[i], da_lk2[i], da_subln_w[i],
                               da_w_o[i], lambda_init)
        merged = (gates[:, :, 0] * y_a.astype(jnp.float32)
                  + gates[:, :, 1] * y_b.astype(jnp.float32)).astype(x.dtype)
        x = x + merged @ w_out[i]
        h = rmsnorm(x, norm_ffn[i])
        x = x + jnp.square(jax.nn.relu(h @ w_ff1[i])) @ w_ff2[i]
        h = rmsnorm(x, norm_ple[i])
        x = x + jax.nn.sigmoid(h @ w_ple_gate[i]) * (p[i] @ w_ple_proj[i])
    return rmsnorm(x, norm_final)
```

```cpp
#include <hip/hip_runtime.h>
#include <hip/hip_cooperative_groups.h>
#include <cstdio>
namespace cg = cooperative_groups;

#define DI __device__ __forceinline__
typedef __attribute__((ext_vector_type(8))) short bf16x8;
typedef __attribute__((ext_vector_type(4))) short s16x4;
typedef __attribute__((ext_vector_type(16))) float f32x16;
typedef unsigned short bf16_t;
typedef unsigned u32x4 __attribute__((ext_vector_type(4)));

#define MFMA32(a, b, c) __builtin_amdgcn_mfma_f32_32x32x16_bf16((a), (b), (c), 0, 0, 0)

constexpr int T = 16384;
constexpr int SEQ = 8192;
constexpr int DM = 1024;
constexpr int NTHREADS = 256;

constexpr size_t OFF_WIN = 0;
constexpr size_t OFF_W1 = 11272192;
constexpr size_t OFF_W2F = 19660800;
constexpr size_t OFF_WOUT = 28049408;
constexpr size_t OFF_WPG = 30146560;
constexpr size_t OFF_WPP = 32243712;
constexpr size_t OFF_WOA = 32768000;
constexpr size_t OFF_WOB = 33816576;
constexpr size_t OFF_W2T = 34865152;
constexpr size_t OFF_A2T = 34996224;
constexpr size_t OFF_G2T = 35127296;
constexpr size_t OFF_SMALL = 35258368;
constexpr size_t OFF_S = 36306944;
constexpr size_t SLOT = 16777216;
constexpr size_t OFF_Q = 187301888;
constexpr size_t OFF_K = 204079104;
constexpr size_t OFF_VT = 220856320;
constexpr size_t OFF_AWD = 237633536;
constexpr size_t OFF_AAD = 241827840;
constexpr size_t OFF_AGD = 246022144;
constexpr size_t OFF_YB = 250216448;
constexpr size_t OFF_KTMP = OFF_YB;
constexpr size_t OFF_YA = OFF_Q;
constexpr size_t OFF_MERGED = OFF_K;
constexpr size_t OFF_XB = OFF_S;
constexpr size_t OFF_HFF = OFF_S + 33554432;
constexpr size_t OFF_H0 = OFF_S + 7 * SLOT;

struct Params {
  const float* in[31];
  float* out;
  unsigned char* ws;
};

DI bf16_t f2bf(float x) {
  unsigned u = __float_as_uint(x);
  u += 0x7fffu + ((u >> 16) & 1u);
  return (bf16_t)(u >> 16);
}
DI float bf2f(unsigned b) { return __uint_as_float(b << 16); }
typedef __bf16 bf16x2v __attribute__((ext_vector_type(2)));
typedef float f32x2v __attribute__((ext_vector_type(2)));
DI unsigned pack2(float a, float b) {
  f32x2v f = {a, b};
  bf16x2v r = __builtin_convertvector(f, bf16x2v);
  return __builtin_bit_cast(unsigned, r);
}
DI uint2 pack4(float a, float b, float c, float d) { return make_uint2(pack2(a, b), pack2(c, d)); }
DI float4 unpack4(uint2 v) {
  return make_float4(bf2f(v.x & 0xffffu), bf2f(v.x >> 16), bf2f(v.y & 0xffffu), bf2f(v.y >> 16));
}
DI float sigmoidf_(float x) { return 1.0f / (1.0f + __expf(-x)); }
DI unsigned xb_xcc_id();
DI int otid() { int t = threadIdx.x; asm volatile("" : "+v"(t)); return t; }
DI int crow(int i, int hh) { return (i & 3) + 8 * (i >> 2) + 4 * hh; }

template <int CTRL>
DI float dpp_add(float p) {
  int q = __builtin_amdgcn_update_dpp(0, __float_as_int(p), CTRL, 0xf, 0xf, false);
  return p + __int_as_float(q);
}
DI float row16_sum(float p) {
  p = dpp_add<0x128>(p);
  p = dpp_add<0x124>(p);
  p = dpp_add<0x122>(p);
  p = dpp_add<0x121>(p);
  return p;
}
DI float xor32_sum(float v) {
  auto r = __builtin_amdgcn_permlane32_swap(__float_as_uint(v), __float_as_uint(v), false, false);
  return __uint_as_float(r[0]) + __uint_as_float(r[1]);
}
DI float xor32_max(float v) {
  auto r = __builtin_amdgcn_permlane32_swap(__float_as_uint(v), __float_as_uint(v), false, false);
  return fmaxf(__uint_as_float(r[0]), __uint_as_float(r[1]));
}
DI float half32_sum(float v) {
  v = row16_sum(v);
  auto r = __builtin_amdgcn_permlane16_swap(__float_as_uint(v), __float_as_uint(v), false, false);
  return __uint_as_float(r[0]) + __uint_as_float(r[1]);
}
DI float wave_sum(float v) { return xor32_sum(half32_sum(v)); }

constexpr int LDT = 72;
constexpr int LDC = 132;
constexpr int SMEM_BYTES = 2 * 2 * 128 * LDT * 2;

template <bool AF32, int PROBE = 0, bool PF2 = true>
DI void gemm_tile(f32x16 (&acc)[2][2], const void* __restrict__ Aptr, int lda,
                  const bf16_t* __restrict__ Bt, int ldb, int K, int m0, unsigned char* smem) {
  const int tid = otid(), lane = tid & 63, wave = tid >> 6;
  const int wm = wave >> 1, wn = wave & 1;
  bf16_t* As = (bf16_t*)smem;
  bf16_t* Bs = As + 2 * 128 * LDT;
  const int nk = K >> 6;
  const bf16_t* A16 = (const bf16_t*)Aptr;
  const float* A32 = (const float*)Aptr;
  const unsigned aoff32 = AF32 ? (unsigned)((tid >> 4) * lda + (tid & 15) * 4) : (unsigned)((tid >> 3) * lda + (tid & 7) * 8);
  const unsigned boff32 = (unsigned)((tid >> 3) * ldb + (tid & 7) * 8);
  const float* A32b = A32 + (size_t)m0 * lda;
  const bf16_t* A16b = A16 + (size_t)m0 * lda;
#define GL32(p, kt_) { \
    const float* ab_ = A32b + (kt_) * 64; \
    p##f0 = *(const float4*)(ab_ + (aoff32 + (unsigned)(0 * 16 * lda))); \
    p##f1 = *(const float4*)(ab_ + (aoff32 + (unsigned)(1 * 16 * lda))); \
    p##f2 = *(const float4*)(ab_ + (aoff32 + (unsigned)(2 * 16 * lda))); \
    p##f3 = *(const float4*)(ab_ + (aoff32 + (unsigned)(3 * 16 * lda))); \
    p##f4 = *(const float4*)(ab_ + (aoff32 + (unsigned)(4 * 16 * lda))); \
    p##f5 = *(const float4*)(ab_ + (aoff32 + (unsigned)(5 * 16 * lda))); \
    p##f6 = *(const float4*)(ab_ + (aoff32 + (unsigned)(6 * 16 * lda))); \
    p##f7 = *(const float4*)(ab_ + (aoff32 + (unsigned)(7 * 16 * lda))); \
    const bf16_t* bb_ = Bt + (kt_) * 64; \
    p##b0 = *(const uint4*)(bb_ + (boff32 + (unsigned)(0 * 32 * ldb))); \
    p##b1 = *(const uint4*)(bb_ + (boff32 + (unsigned)(1 * 32 * ldb))); \
    p##b2 = *(const uint4*)(bb_ + (boff32 + (unsigned)(2 * 32 * ldb))); \
    p##b3 = *(const uint4*)(bb_ + (boff32 + (unsigned)(3 * 32 * ldb))); }
#define GL16(p, kt_) { \
    const bf16_t* ab_ = A16b + (kt_) * 64; \
    p##a0 = *(const uint4*)(ab_ + (aoff32 + (unsigned)(0 * 32 * lda))); \
    p##a1 = *(const uint4*)(ab_ + (aoff32 + (unsigned)(1 * 32 * lda))); \
    p##a2 = *(const uint4*)(ab_ + (aoff32 + (unsigned)(2 * 32 * lda))); \
    p##a3 = *(const uint4*)(ab_ + (aoff32 + (unsigned)(3 * 32 * lda))); \
    const bf16_t* bb_ = Bt + (kt_) * 64; \
    p##b0 = *(const uint4*)(bb_ + (boff32 + (unsigned)(0 * 32 * ldb))); \
    p##b1 = *(const uint4*)(bb_ + (boff32 + (unsigned)(1 * 32 * ldb))); \
    p##b2 = *(const uint4*)(bb_ + (boff32 + (unsigned)(2 * 32 * ldb))); \
    p##b3 = *(const uint4*)(bb_ + (boff32 + (unsigned)(3 * 32 * ldb))); }
#define SW32(p, buf_) { \
    bf16_t* d_ = As + (buf_) * 128 * LDT + (tid >> 4) * LDT + (tid & 15) * 4; \
    *(uint2*)(d_ + 0 * 16 * LDT) = pack4(p##f0.x, p##f0.y, p##f0.z, p##f0.w); \
    *(uint2*)(d_ + 1 * 16 * LDT) = pack4(p##f1.x, p##f1.y, p##f1.z, p##f1.w); \
    *(uint2*)(d_ + 2 * 16 * LDT) = pack4(p##f2.x, p##f2.y, p##f2.z, p##f2.w); \
    *(uint2*)(d_ + 3 * 16 * LDT) = pack4(p##f3.x, p##f3.y, p##f3.z, p##f3.w); \
    *(uint2*)(d_ + 4 * 16 * LDT) = pack4(p##f4.x, p##f4.y, p##f4.z, p##f4.w); \
    *(uint2*)(d_ + 5 * 16 * LDT) = pack4(p##f5.x, p##f5.y, p##f5.z, p##f5.w); \
    *(uint2*)(d_ + 6 * 16 * LDT) = pack4(p##f6.x, p##f6.y, p##f6.z, p##f6.w); \
    *(uint2*)(d_ + 7 * 16 * LDT) = pack4(p##f7.x, p##f7.y, p##f7.z, p##f7.w); \
    bf16_t* d2_ = Bs + (buf_) * 128 * LDT + (tid >> 3) * LDT + (tid & 7) * 8; \
    *(uint4*)(d2_ + 0 * 32 * LDT) = p##b0; *(uint4*)(d2_ + 1 * 32 * LDT) = p##b1; \
    *(uint4*)(d2_ + 2 * 32 * LDT) = p##b2; *(uint4*)(d2_ + 3 * 32 * LDT) = p##b3; }
#define SW16(p, buf_) { \
    bf16_t* d_ = As + (buf_) * 128 * LDT + (tid >> 3) * LDT + (tid & 7) * 8; \
    *(uint4*)(d_ + 0 * 32 * LDT) = p##a0; *(uint4*)(d_ + 1 * 32 * LDT) = p##a1; \
    *(uint4*)(d_ + 2 * 32 * LDT) = p##a2; *(uint4*)(d_ + 3 * 32 * LDT) = p##a3; \
    bf16_t* d2_ = Bs + (buf_) * 128 * LDT + (tid >> 3) * LDT + (tid & 7) * 8; \
    *(uint4*)(d2_ + 0 * 32 * LDT) = p##b0; *(uint4*)(d2_ + 1 * 32 * LDT) = p##b1; \
    *(uint4*)(d2_ + 2 * 32 * LDT) = p##b2; *(uint4*)(d2_ + 3 * 32 * LDT) = p##b3; }
  auto compute = [&](int buf) __attribute__((always_inline)) {
    const bf16_t* as = As + buf * 128 * LDT + (wm * 64 + (lane & 31)) * LDT + (lane >> 5) * 8;
    const bf16_t* bs = Bs + buf * 128 * LDT + (wn * 64 + (lane & 31)) * LDT + (lane >> 5) * 8;
#pragma unroll
    for (int ks = 0; ks < 4; ++ks) {
      bf16x8 a0 = *(const bf16x8*)(as + ks * 16);
      bf16x8 a1 = *(const bf16x8*)(as + 32 * LDT + ks * 16);
      bf16x8 b0 = *(const bf16x8*)(bs + ks * 16);
      bf16x8 b1 = *(const bf16x8*)(bs + 32 * LDT + ks * 16);
      acc[0][0] = MFMA32(a0, b0, acc[0][0]);
      acc[0][1] = MFMA32(a0, b1, acc[0][1]);
      acc[1][0] = MFMA32(a1, b0, acc[1][0]);
      acc[1][1] = MFMA32(a1, b1, acc[1][1]);
    }
  };
  __syncthreads();
  if (AF32) {
    float4 sf0, sf1, sf2, sf3, sf4, sf5, sf6, sf7;
    uint4 sb0, sb1, sb2, sb3;
    GL32(s, 0);
    SW32(s, 0);
    __syncthreads();
#pragma unroll 1
    for (int kt = 0; kt < nk - 1; ++kt) {
      const int buf = kt & 1;
      GL32(s, kt + 1);
      __builtin_amdgcn_sched_barrier(0);
      compute(buf);
      SW32(s, buf ^ 1);
      __syncthreads();
    }
    compute((nk - 1) & 1);
    __syncthreads();
  } else if (!PF2) {
    uint4 pa0, pa1, pa2, pa3, pb0, pb1, pb2, pb3;
    GL16(p, 0);
    SW16(p, 0);
    __syncthreads();
#pragma unroll 1
    for (int kt = 0; kt < nk - 1; ++kt) {
      const int buf = kt & 1;
      GL16(p, kt + 1);
      __builtin_amdgcn_sched_barrier(0);
      compute(buf);
      SW16(p, buf ^ 1);
      __syncthreads();
    }
    compute((nk - 1) & 1);
    __syncthreads();
  } else {
    uint4 pa0, pa1, pa2, pa3, pb0, pb1, pb2, pb3;
    uint4 qa0, qa1, qa2, qa3, qb0, qb1, qb2, qb3;
    GL16(p, 0);
    if (nk > 1) GL16(q, 1);
    SW16(p, 0);
    __syncthreads();
    int kt = 0;
#pragma unroll 1
    for (; kt + 2 < nk; kt += 2) {
      GL16(p, kt + 2);
      __builtin_amdgcn_sched_barrier(0);
      compute(0);
      SW16(q, 1);
      __syncthreads();
      if (kt + 3 < nk) GL16(q, kt + 3);
      __builtin_amdgcn_sched_barrier(0);
      compute(1);
      SW16(p, 0);
      __syncthreads();
    }
    if (kt + 1 < nk) {
      compute(0);
      SW16(q, 1);
      __syncthreads();
      compute(1);
      __syncthreads();
    } else {
      compute(0);
      __syncthreads();
    }
  }
#undef GL32
#undef GL16
#undef SW32
#undef SW16
}

DI void zero_acc(f32x16 (&acc)[2][2]) {
#pragma unroll
  for (int a = 0; a < 2; ++a)
#pragma unroll
    for (int b = 0; b < 2; ++b)
#pragma unroll
      for (int i = 0; i < 16; ++i) acc[a][b][i] = 0.f;
}

DI void stage_acc(const f32x16 (&acc)[2][2], unsigned char* smem) {
  const int tid = otid(), lane = tid & 63, wave = tid >> 6;
  const int wm = wave >> 1, wn = wave & 1, hh = lane >> 5;
  float* Cs = (float*)smem;
#pragma unroll
  for (int mi = 0; mi < 2; ++mi)
#pragma unroll
    for (int ni = 0; ni < 2; ++ni)
#pragma unroll
      for (int i = 0; i < 16; ++i)
        Cs[(wm * 64 + mi * 32 + crow(i, hh)) * LDC + wn * 64 + ni * 32 + (lane & 31)] = acc[mi][ni][i];
  __syncthreads();
}

DI void gemm_tile256(f32x16 (&acc)[4][2], const bf16_t* __restrict__ A16, int lda,
                     const bf16_t* __restrict__ Bt, int ldb, int K, int m0, unsigned char* smem) {
  const int tid = otid(), lane = tid & 63, wave = tid >> 6;
  const int wm = wave >> 1, wn = wave & 1;
  bf16_t* As = (bf16_t*)smem;
  bf16_t* Bs = As + 256 * LDT;
  const int nk = K >> 6;
  const unsigned aoff32 = (unsigned)((tid >> 3) * lda + (tid & 7) * 8);
  const unsigned boff32 = (unsigned)((tid >> 3) * ldb + (tid & 7) * 8);
  const bf16_t* A16b = A16 + (size_t)m0 * lda;
  uint4 a0, a1, a2, a3, a4, a5, a6, a7, b0, b1, b2, b3;
#define GL256(kt_) { \
    const bf16_t* ab_ = A16b + (kt_) * 64; \
    a0 = *(const uint4*)(ab_ + (aoff32 + (unsigned)(0 * 32 * lda))); \
    a1 = *(const uint4*)(ab_ + (aoff32 + (unsigned)(1 * 32 * lda))); \
    a2 = *(const uint4*)(ab_ + (aoff32 + (unsigned)(2 * 32 * lda))); \
    a3 = *(const uint4*)(ab_ + (aoff32 + (unsigned)(3 * 32 * lda))); \
    a4 = *(const uint4*)(ab_ + (aoff32 + (unsigned)(4 * 32 * lda))); \
    a5 = *(const uint4*)(ab_ + (aoff32 + (unsigned)(5 * 32 * lda))); \
    a6 = *(const uint4*)(ab_ + (aoff32 + (unsigned)(6 * 32 * lda))); \
    a7 = *(const uint4*)(ab_ + (aoff32 + (unsigned)(7 * 32 * lda))); \
    const bf16_t* bb_ = Bt + (kt_) * 64; \
    b0 = *(const uint4*)(bb_ + (boff32 + (unsigned)(0 * 32 * ldb))); \
    b1 = *(const uint4*)(bb_ + (boff32 + (unsigned)(1 * 32 * ldb))); \
    b2 = *(const uint4*)(bb_ + (boff32 + (unsigned)(2 * 32 * ldb))); \
    b3 = *(const uint4*)(bb_ + (boff32 + (unsigned)(3 * 32 * ldb))); }
#define SW256() { \
    bf16_t* d_ = As + (tid >> 3) * LDT + (tid & 7) * 8; \
    *(uint4*)(d_ + 0 * 32 * LDT) = a0; *(uint4*)(d_ + 1 * 32 * LDT) = a1; \
    *(uint4*)(d_ + 2 * 32 * LDT) = a2; *(uint4*)(d_ + 3 * 32 * LDT) = a3; \
    *(uint4*)(d_ + 4 * 32 * LDT) = a4; *(uint4*)(d_ + 5 * 32 * LDT) = a5; \
    *(uint4*)(d_ + 6 * 32 * LDT) = a6; *(uint4*)(d_ + 7 * 32 * LDT) = a7; \
    bf16_t* d2_ = Bs + (tid >> 3) * LDT + (tid & 7) * 8; \
    *(uint4*)(d2_ + 0 * 32 * LDT) = b0; *(uint4*)(d2_ + 1 * 32 * LDT) = b1; \
    *(uint4*)(d2_ + 2 * 32 * LDT) = b2; *(uint4*)(d2_ + 3 * 32 * LDT) = b3; }
  auto compute = [&]() __attribute__((always_inline)) {
    const bf16_t* as = As + (wm * 128 + (lane & 31)) * LDT + (lane >> 5) * 8;
    const bf16_t* bs = Bs + (wn * 64 + (lane & 31)) * LDT + (lane >> 5) * 8;
#pragma unroll
    for (int ks = 0; ks < 4; ++ks) {
      bf16x8 fb0 = *(const bf16x8*)(bs + ks * 16);
      bf16x8 fb1 = *(const bf16x8*)(bs + 32 * LDT + ks * 16);
      bf16x8 fa0 = *(const bf16x8*)(as + ks * 16);
      bf16x8 fa1 = *(const bf16x8*)(as + 32 * LDT + ks * 16);
      bf16x8 fa2 = *(const bf16x8*)(as + 64 * LDT + ks * 16);
      bf16x8 fa3 = *(const bf16x8*)(as + 96 * LDT + ks * 16);
      acc[0][0] = MFMA32(fa0, fb0, acc[0][0]);
      acc[0][1] = MFMA32(fa0, fb1, acc[0][1]);
      acc[1][0] = MFMA32(fa1, fb0, acc[1][0]);
      acc[1][1] = MFMA32(fa1, fb1, acc[1][1]);
      acc[2][0] = MFMA32(fa2, fb0, acc[2][0]);
      acc[2][1] = MFMA32(fa2, fb1, acc[2][1]);
      acc[3][0] = MFMA32(fa3, fb0, acc[3][0]);
      acc[3][1] = MFMA32(fa3, fb1, acc[3][1]);
    }
  };
  __syncthreads();
  GL256(0);
  SW256();
  __syncthreads();
#pragma unroll 1
  for (int kt = 0; kt < nk - 1; ++kt) {
    GL256(kt + 1);
    __builtin_amdgcn_sched_barrier(0);
    compute();
    __syncthreads();
    SW256();
    __syncthreads();
  }
  compute();
  __syncthreads();
#undef GL256
#undef SW256
}

DI void zero_acc256(f32x16 (&acc)[4][2]) {
#pragma unroll
  for (int a = 0; a < 4; ++a)
#pragma unroll
    for (int b = 0; b < 2; ++b)
#pragma unroll
      for (int i = 0; i < 16; ++i) acc[a][b][i] = 0.f;
}

DI void stage_half(const f32x16 (&acc)[4][2], int hsel, unsigned char* smem) {
  const int tid = otid(), lane = tid & 63, wave = tid >> 6;
  const int wm = wave >> 1, wn = wave & 1, hh = lane >> 5;
  float* Cs = (float*)smem;
  if (wm == hsel) {
#pragma unroll
    for (int mi = 0; mi < 4; ++mi)
#pragma unroll
      for (int ni = 0; ni < 2; ++ni)
#pragma unroll
        for (int i = 0; i < 16; ++i)
          Cs[(mi * 32 + crow(i, hh)) * LDC + wn * 64 + ni * 32 + (lane & 31)] = acc[mi][ni][i];
  }
  __syncthreads();
}

DI void transpose_job(const float* __restrict__ src, bf16_t* __restrict__ dst, int K, int N,
                      const float* __restrict__ sc, int local, float* tile) {
  const int tid = otid();
  const int ntn = N >> 6;
  const int tk = local / ntn, tn = local - tk * ntn;
#pragma unroll
  for (int i = 0; i < 16; ++i) {
    int r = (tid >> 6) + 4 * i;
    float v = src[(size_t)(tk * 64 + r) * N + tn * 64 + (tid & 63)];
    if (sc) v *= sc[tk * 64 + r];
    tile[r * 65 + (tid & 63)] = v;
  }
  __syncthreads();
#pragma unroll
  for (int i = 0; i < 16; ++i) {
    int n = (tid >> 6) + 4 * i;
    dst[(size_t)(tn * 64 + n) * K + tk * 64 + (tid & 63)] = f2bf(tile[(tid & 63) * 65 + n]);
  }
  __syncthreads();
}

constexpr int NT_EARLY = 1376 + 16 + 16;
constexpr int NT_LATE = 1024 + 1024 + 256 + 256 + 64 + 128 + 128 + 16;
DI void transpose_early(const Params& P, int l, float* tile) {
  unsigned char* ws = P.ws;
  if (l < 1376) { transpose_job(P.in[3], (bf16_t*)(ws + OFF_WIN), 1024, 5504, P.in[2], l, tile); return; }
  l -= 1376;
  if (l < 16) { int d = l >> 3; transpose_job(P.in[7] + d * 64 * 512, (bf16_t*)(ws + OFF_W2T) + d * 512 * 64, 64, 512, nullptr, l & 7, tile); return; }
  l -= 16;
  { int d = l >> 3; transpose_job(P.in[9] + d * 64 * 512, (bf16_t*)(ws + OFF_A2T) + d * 512 * 64, 64, 512, nullptr, l & 7, tile); }
}
DI void transpose_late(const Params& P, int l, float* tile) {
  unsigned char* ws = P.ws;
  if (l < 1024) { transpose_job(P.in[25], (bf16_t*)(ws + OFF_W1), 1024, 4096, P.in[24], l, tile); return; }
  l -= 1024;
  if (l < 1024) { transpose_job(P.in[26], (bf16_t*)(ws + OFF_W2F), 4096, 1024, nullptr, l, tile); return; }
  l -= 1024;
  if (l < 256) { transpose_job(P.in[23], (bf16_t*)(ws + OFF_WOUT), 1024, 1024, nullptr, l, tile); return; }
  l -= 256;
  if (l < 256) { transpose_job(P.in[28], (bf16_t*)(ws + OFF_WPG), 1024, 1024, P.in[27], l, tile); return; }
  l -= 256;
  if (l < 64) { transpose_job(P.in[29], (bf16_t*)(ws + OFF_WPP), 256, 1024, nullptr, l, tile); return; }
  l -= 64;
  if (l < 128) { transpose_job(P.in[16], (bf16_t*)(ws + OFF_WOA), 512, 1024, nullptr, l, tile); return; }
  l -= 128;
  if (l < 128) { transpose_job(P.in[22], (bf16_t*)(ws + OFF_WOB), 512, 1024, nullptr, l, tile); return; }
  l -= 128;
  transpose_job(P.in[10], (bf16_t*)(ws + OFF_G2T), 128, 512, nullptr, l, tile);
}

DI void phase_prep(const Params& P, unsigned char* smem) {
  float* tile = (float*)smem;
  unsigned char* ws = P.ws;
  const int tid = otid(), lane = tid & 63, wave = tid >> 6;
  for (int w = blockIdx.x; w < NT_EARLY; w += gridDim.x) transpose_early(P, w, tile);
  float* small = (float*)(ws + OFF_SMALL);
  const float* x = P.in[0];
  for (int row = blockIdx.x * 4 + wave; row < T; row += gridDim.x * 4) {
    float s = 0.f;
#pragma unroll
    for (int i = 0; i < 4; ++i) {
      float4 v = *(const float4*)(x + (size_t)row * DM + (lane + 64 * i) * 4);
      s += v.x * v.x + v.y * v.y + v.z * v.z + v.w * v.w;
      *(uint2*)((bf16_t*)(ws + OFF_H0) + (size_t)row * DM + (lane + 64 * i) * 4) = pack4(v.x, v.y, v.z, v.w);
    }
    s = wave_sum(s);
    if (lane == 0) small[row] = rsqrtf(s * (1.0f / 1024.0f) + 1e-6f);
  }
  for (int i = blockIdx.x * NTHREADS + tid; i < 3 * T + 64; i += gridDim.x * NTHREADS) small[T + i] = 0.f;
}

__device__ __constant__ float c_invf[8] = {1.0f, 0.19392274474868576f, 0.03760603093086393f, 0.007292664737217109f,
                                           0.001414213562373095f, 0.0002742481756762073f, 5.318295896944988e-05f,
                                           1.031338537721246e-05f};

DI void rope_sincos(float ang, float& c, float& s) {
  float n = rintf(ang * 0.15915494309189535f);
  float r = fmaf(-n, 6.2831855f, ang);
  r = fmaf(-n, -1.7484555e-07f, r);
  s = __sinf(r);
  c = __cosf(r);
}

DI void phase_p1(const Params& P, unsigned char* smem) {
  unsigned char* ws = P.ws;
  const int tid = otid();
  const float* x = P.in[0];
  const bf16_t* WinT = (const bf16_t*)(ws + OFF_WIN);
  const float* rstd0 = (const float*)(ws + OFF_SMALL);
  bf16_t* UR = (bf16_t*)P.out;
  bf16_t* Qb = (bf16_t*)(ws + OFF_Q);
  bf16_t* Kb = (bf16_t*)(ws + OFF_K);
  bf16_t* Vt = (bf16_t*)(ws + OFF_VT);
  const float* Cs = (const float*)smem;
  constexpr float QSCALE = 0.18033688011112042f;
  const bool xmap = (gridDim.x == 512);
  for (int tile = blockIdx.x; tile < (xmap ? 512 * 7 : 128 * 27); tile += gridDim.x) {
    int nt, mt;
    if (xmap) {
      const int x = tile & 7, j = tile >> 3;
      if (j >= 432) continue;
      int ml;
      if (j < 384) { const int s = j >> 6, q = j & 63; nt = (s >> 1) * 8 + (q >> 3); ml = (s & 1) * 8 + (q & 7); }
      else { const int r = j - 384; nt = 24 + (r >> 4); ml = r & 15; }
      mt = x * 16 + ml;
    } else {
      nt = tile % 27; mt = tile / 27;
    }
    const int m0 = mt * 128;
    f32x16 acc[2][2];
    zero_acc(acc);
    gemm_tile<false>(acc, (const bf16_t*)(ws + OFF_H0), DM, WinT + (size_t)nt * 128 * DM, DM, DM, m0, smem);
    stage_acc(acc, smem);
    const int b = m0 >> 13;
    if (nt >= 15 && nt < 23) {
      float* Cw = (float*)smem;
#pragma unroll 2
      for (int it = 0; it < 8; ++it) {
        const int idx = tid + 256 * it;
        const int fi = idx & 7, hl = (idx >> 3) & 1, row = idx >> 4;
        const int pos = (m0 + row) & (SEQ - 1);
        float c, s;
        rope_sincos((float)pos * c_invf[fi], c, s);
        float* p1 = Cw + row * LDC + hl * 64 + fi;
        const float x1 = p1[0], x2 = p1[8];
        p1[0] = x1 * c - x2 * s;
        p1[8] = x2 * c + x1 * s;
      }
      __syncthreads();
    }
    if (nt < 23) {
#pragma unroll 4
      for (int it = 0; it < 16; ++it) {
        int idx = tid + 256 * it, row = idx >> 5, c4 = (idx & 31) * 4;
        int grow = m0 + row;
        float rs = rstd0[grow];
        float4 v = *(const float4*)(Cs + row * LDC + c4);
        v.x *= rs; v.y *= rs; v.z *= rs; v.w *= rs;
        if (nt < 15) {
          *(uint2*)(UR + (size_t)grow * 1920 + nt * 128 + c4) = pack4(v.x, v.y, v.z, v.w);
        } else {
          const bool isq = nt < 19;
          const int hc = (nt - (isq ? 15 : 19)) * 2 + (c4 >> 6);
          const int d = c4 & 63;
          const int pos = grow & (SEQ - 1);
          if (isq) { v.x *= QSCALE; v.y *= QSCALE; v.z *= QSCALE; v.w *= QSCALE; }
          bf16_t* dst = (isq ? Qb : Kb) + ((size_t)(b * 8 + hc) * SEQ + pos) * 64 + d;
          *(uint2*)dst = pack4(v.x, v.y, v.z, v.w);
        }
      }
    } else {
      const int h = nt - 23;
      const int s0 = m0 & (SEQ - 1);
#pragma unroll 2
      for (int it = 0; it < 8; ++it) {
        int idx = tid + 256 * it, dv = idx & 127, rg = idx >> 7;
        float vals[8];
#pragma unroll
        for (int j = 0; j < 8; ++j) vals[j] = Cs[(rg * 8 + j) * LDC + dv] * rstd0[m0 + rg * 8 + j];
        uint4 o;
        o.x = pack2(vals[0], vals[1]); o.y = pack2(vals[2], vals[3]);
        o.z = pack2(vals[4], vals[5]); o.w = pack2(vals[6], vals[7]);
        *(uint4*)(Vt + ((size_t)(b * 4 + h) * 128 + dv) * SEQ + s0 + rg * 8) = o;
      }
    }
  }
}

DI void phase_e1(const Params& P) {
  unsigned char* ws = P.ws;
  const int tid = otid(), lane = tid & 63, wave = tid >> 6;
  const bf16_t* UR = (const bf16_t*)P.out;
  const float* mup = P.in[4];
  const float* mun = P.in[5];
  const float* k_k = P.in[11];
  bf16_t* R = (bf16_t*)(ws + OFF_S);
  bf16_t* V = R + (size_t)T * 512;
  bf16_t* NKK = V + (size_t)T * 512;
  bf16_t* KT = (bf16_t*)(ws + OFF_KTMP);
  bf16_t* AWD = (bf16_t*)(ws + OFF_AWD);
  bf16_t* AAD = (bf16_t*)(ws + OFF_AAD);
  bf16_t* AGD = (bf16_t*)(ws + OFF_AGD);
  const float4 zero4 = make_float4(0.f, 0.f, 0.f, 0.f);
  for (int g = blockIdx.x * 4 + wave; g < T / 8; g += gridDim.x * 4) {
    const int t0 = g * 8;
#pragma unroll
    for (int i = 0; i < 8; ++i) {
      const int c = 4 * lane + 256 * i;
      if (c < 1920) {
        const float4 mp = *(const float4*)(mup + c);
        const float4 mn = *(const float4*)(mun + c);
        float4 kk4 = zero4;
        if (i == 2 || i == 3) kk4 = *(const float4*)(k_k + (c - 512));
        const bf16_t* up_ = UR + (size_t)t0 * 1920 + c;
        float4 prv = ((t0 & (SEQ - 1)) > 0) ? unpack4(*(const uint2*)(up_ - 1920)) : zero4;
        float4 u = unpack4(*(const uint2*)(up_));
#pragma unroll
        for (int tt = 0; tt < 8; ++tt) {
          const int t = t0 + tt;
          const float4 un = ((t & (SEQ - 1)) < SEQ - 1) ? unpack4(*(const uint2*)(up_ + (size_t)(tt + 1) * 1920)) : zero4;
          float4 s;
          s.x = u.x + mp.x * (prv.x - u.x) + mn.x * (un.x - u.x);
          s.y = u.y + mp.y * (prv.y - u.y) + mn.y * (un.y - u.y);
          s.z = u.z + mp.z * (prv.z - u.z) + mn.z * (un.z - u.z);
          s.w = u.w + mp.w * (prv.w - u.w) + mn.w * (un.w - u.w);
          if (i < 2) {
            *(uint2*)(R + (size_t)t * 512 + c) = pack4(s.x, s.y, s.z, s.w);
          } else if (i < 4) {
            const int cc = c - 512;
            float4 q = make_float4(s.x * kk4.x, s.y * kk4.y, s.z * kk4.z, s.w * kk4.w);
            float ss = q.x * q.x + q.y * q.y + q.z * q.z + q.w * q.w;
            ss = row16_sum(ss);
            float inv = -1.0f / fmaxf(sqrtf(ss), 1e-12f);
            *(uint2*)(KT + (size_t)t * 512 + cc) = pack4(s.x, s.y, s.z, s.w);
            *(uint2*)(NKK + (size_t)t * 512 + cc) = pack4(q.x * inv, q.y * inv, q.z * inv, q.w * inv);
          } else if (i < 6) {
            *(uint2*)(V + (size_t)t * 512 + (c - 1024)) = pack4(s.x, s.y, s.z, s.w);
          } else if (c < 1664) {
            float4 o;
            o.x = 1.f - 2.f / (1.f + __expf(2.f * s.x)); o.y = 1.f - 2.f / (1.f + __expf(2.f * s.y));
            o.z = 1.f - 2.f / (1.f + __expf(2.f * s.z)); o.w = 1.f - 2.f / (1.f + __expf(2.f * s.w));
            *(uint2*)(AWD + (size_t)t * 128 + (c - 1536)) = pack4(o.x, o.y, o.z, o.w);
          } else if (c < 1792) {
            *(uint2*)(AAD + (size_t)t * 128 + (c - 1664)) = pack4(s.x, s.y, s.z, s.w);
          } else {
            *(uint2*)(AGD + (size_t)t * 128 + (c - 1792)) =
                pack4(sigmoidf_(s.x), sigmoidf_(s.y), sigmoidf_(s.z), sigmoidf_(s.w));
          }
          prv = u;
          u = un;
        }
      }
    }
  }
}

DI void phase_lora(const Params& P, unsigned char* smem) {
  unsigned char* ws = P.ws;
  const int tid = otid();
  const float* Cs = (const float*)smem;
  bf16_t* Sb = (bf16_t*)(ws + OFF_S);
  const bf16_t* NKK = Sb + 2 * (size_t)T * 512;
  const bf16_t* KT = (const bf16_t*)(ws + OFF_KTMP);
  const float* w0 = P.in[6];
  const float* a0 = P.in[8];
  const float* k_a = P.in[12];
  for (int item = blockIdx.x; item < 128 * 16; item += gridDim.x) {
    const int kind = item & 3, nt = (item >> 2) & 3, mt = item >> 4;
    const int d = kind & 1;
    const bool isdecay = kind < 2;
    const int m0 = mt * 128;
    const bf16_t* A = (const bf16_t*)(ws + (isdecay ? OFF_AWD : OFF_AAD)) + d * 64;
    const bf16_t* Bt = (const bf16_t*)(ws + (isdecay ? OFF_W2T : OFF_A2T)) + (size_t)d * 512 * 64 + (size_t)nt * 128 * 64;
    f32x16 acc[2][2];
    zero_acc(acc);
    gemm_tile<false>(acc, A, 128, Bt, 64, 64, m0, smem);
    stage_acc(acc, smem);
    bf16_t* E = Sb + (size_t)(3 + d) * T * 512;
    bf16_t* KD = Sb + (size_t)(5 + d) * T * 512;
    bf16_t* BB = Sb + (size_t)(7 + d) * T * 512;
#pragma unroll 4
    for (int it = 0; it < 16; ++it) {
      int idx = tid + 256 * it, row = idx >> 5, c4 = (idx & 31) * 4;
      size_t grow = m0 + row;
      int c = nt * 128 + c4;
      float4 v = *(const float4*)(Cs + row * LDC + c4);
      if (isdecay) {
        float4 b4 = *(const float4*)(w0 + d * 512 + c);
        const float E5 = 0.6065306597126334f;
        *(uint2*)(E + grow * 512 + c) = pack4(E5 * sigmoidf_(v.x + b4.x), E5 * sigmoidf_(v.y + b4.y),
                                              E5 * sigmoidf_(v.z + b4.z), E5 * sigmoidf_(v.w + b4.w));
      } else {
        float4 b4 = *(const float4*)(a0 + d * 512 + c);
        float4 ka = *(const float4*)(k_a + c);
        float4 k = unpack4(*(const uint2*)(KT + grow * 512 + c));
        float4 nk = unpack4(*(const uint2*)(NKK + grow * 512 + c));
        float ax = sigmoidf_(v.x + b4.x), ay = sigmoidf_(v.y + b4.y), az = sigmoidf_(v.z + b4.z), aw = sigmoidf_(v.w + b4.w);
        *(uint2*)(KD + grow * 512 + c) = pack4(k.x * (1.f + (ax - 1.f) * ka.x), k.y * (1.f + (ay - 1.f) * ka.y),
                                               k.z * (1.f + (az - 1.f) * ka.z), k.w * (1.f + (aw - 1.f) * ka.w));
        *(uint2*)(BB + grow * 512 + c) = pack4(-nk.x * ax, -nk.y * ay, -nk.z * az, -nk.w * aw);
      }
    }
  }
}

typedef float f2 __attribute__((ext_vector_type(2)));
struct ScanOps { float4 r4, nk, w4, kd, bb; float v; };

template <int DIR>
DI void scan_item(const Params& P, int item, unsigned char* smem) {
  unsigned char* ws = P.ws;
  const int tid = otid(), lane = tid & 63;
  const int wave = __builtin_amdgcn_readfirstlane(tid >> 6);
  const int rg8 = item & 7, h = (item >> 4) & 7, b = item >> 7;
  constexpr int BUFSTRIDE = 5 * 16 * 64 + 16 * 8;
  constexpr int NCH = SEQ / 16;
  float* Xs0 = (float*)smem;
  const bf16_t* Sb = (const bf16_t*)(ws + OFF_S);
  const size_t tokbase = (size_t)b * SEQ;
  if (wave >= 2) {
    const bf16_t* arr0 = Sb;
    const bf16_t* arr1 = Sb + 2 * (size_t)T * 512;
    const bf16_t* arr2 = Sb + (size_t)(3 + DIR) * T * 512;
    const bf16_t* arr3 = Sb + (size_t)(5 + DIR) * T * 512;
    const bf16_t* arr4 = Sb + (size_t)(7 + DIR) * T * 512;
    const bf16_t* Vg = Sb + (size_t)T * 512;
    const int lt = tid - 128;
    const int stp = lt >> 3, part = lt & 7;
    const unsigned loff = (unsigned)(stp * 512 + h * 64 + part * 8);
    const unsigned voff = (unsigned)((lt & 15) * 512 + h * 64 + rg8 * 8);
    uint4 a0, a1, a2, a3, a4, av, b0, b1, b2, b3, b4, bv;
    av = make_uint4(0, 0, 0, 0); bv = av;
#define SCAN_GL(c, r0, r1, r2, r3, r4, rv) { \
      const int tlo_ = DIR ? (SEQ - 16 - 16 * (c)) : 16 * (c); \
      const size_t ub_ = (tokbase + tlo_) * 512; \
      r0 = *(const uint4*)(arr0 + ub_ + loff); r1 = *(const uint4*)(arr1 + ub_ + loff); \
      r2 = *(const uint4*)(arr2 + ub_ + loff); r3 = *(const uint4*)(arr3 + ub_ + loff); \
      r4 = *(const uint4*)(arr4 + ub_ + loff); \
      if (lt < 16) rv = *(const uint4*)(Vg + ub_ + voff); }
    auto st8 = [&](float* dst, uint4 v, bool isw) __attribute__((always_inline)) {
      float f0 = bf2f(v.x & 0xffffu), f1 = bf2f(v.x >> 16), f2_ = bf2f(v.y & 0xffffu), f3 = bf2f(v.y >> 16);
      float f4 = bf2f(v.z & 0xffffu), f5 = bf2f(v.z >> 16), f6 = bf2f(v.w & 0xffffu), f7 = bf2f(v.w >> 16);
      if (isw) {
        f0 = __expf(-f0); f1 = __expf(-f1); f2_ = __expf(-f2_); f3 = __expf(-f3);
        f4 = __expf(-f4); f5 = __expf(-f5); f6 = __expf(-f6); f7 = __expf(-f7);
      }
      *(float4*)(dst) = make_float4(f0, f1, f2_, f3);
      *(float4*)(dst + 4) = make_float4(f4, f5, f6, f7);
    };
#define SCAN_SW(c, r0, r1, r2, r3, r4, rv) { \
      float* X_ = Xs0 + ((c) & 1) * BUFSTRIDE; \
      st8(X_ + (0 * 16 + stp) * 64 + part * 8, r0, false); st8(X_ + (1 * 16 + stp) * 64 + part * 8, r1, false); \
      st8(X_ + (2 * 16 + stp) * 64 + part * 8, r2, true);  st8(X_ + (3 * 16 + stp) * 64 + part * 8, r3, false); \
      st8(X_ + (4 * 16 + stp) * 64 + part * 8, r4, false); \
      if (lt < 16) st8(X_ + 5120 + lt * 8, rv, false); }
    SCAN_GL(0, a0, a1, a2, a3, a4, av);
    SCAN_GL(1, b0, b1, b2, b3, b4, bv);
    SCAN_SW(0, a0, a1, a2, a3, a4, av);
    SCAN_GL(2, a0, a1, a2, a3, a4, av);
    __syncthreads();
#pragma unroll 1
    for (int c = 0; c < NCH; c += 2) {
      if (c + 1 < NCH) SCAN_SW(c + 1, b0, b1, b2, b3, b4, bv);
      if (c + 3 < NCH) SCAN_GL(c + 3, b0, b1, b2, b3, b4, bv);
      __syncthreads();
      if (c + 2 < NCH) SCAN_SW(c + 2, a0, a1, a2, a3, a4, av);
      if (c + 4 < NCH) SCAN_GL(c + 4, a0, a1, a2, a3, a4, av);
      __syncthreads();
    }
#undef SCAN_GL
#undef SCAN_SW
  } else {
    const int cg = lane & 15, rowq = lane >> 4;
    const int rowl = wave * 4 + rowq;
    const int row = rg8 * 8 + rowl;
    bf16_t* Y = (bf16_t*)P.out + (size_t)DIR * T * 512;
    f2 S01 = {0.f, 0.f}, S23 = {0.f, 0.f};
    float ysel = 0.f;
    float4 rprev = make_float4(0.f, 0.f, 0.f, 0.f);
    __syncthreads();
#pragma unroll 1
    for (int c = 0; c < NCH; ++c) {
      const float* xbase = Xs0 + (c & 1) * BUFSTRIDE + cg * 4;
      const float* vbase = Xs0 + (c & 1) * BUFSTRIDE + 5120 + rowl;
      auto ld = [&](ScanOps& o, int j) __attribute__((always_inline)) {
        const int jj = DIR ? 15 - j : j;
        const float* xs = xbase + jj * 64;
        o.r4 = *(const float4*)(xs);
        o.nk = *(const float4*)(xs + 1024);
        o.w4 = *(const float4*)(xs + 2048);
        o.kd = *(const float4*)(xs + 3072);
        o.bb = *(const float4*)(xs + 4096);
        o.v = vbase[jj * 8];
      };
      ScanOps q0, q1, q2;
      ld(q0, 0);
      ld(q1, 1);
#pragma unroll
      for (int j = 0; j < 16; ++j) {
        if (j + 2 < 16) ld(q2, j + 2);
        const ScanOps& cur = q0;
        f2 t = S01 * (f2){cur.nk.x, cur.nk.y};
        t = S23 * (f2){cur.nk.z, cur.nk.w} + t;
        f2 qy = S01 * (f2){rprev.x, rprev.y};
        qy = S23 * (f2){rprev.z, rprev.w} + qy;
        float p = t.x + t.y;
        float y = qy.x + qy.y;
        f2 vv = {cur.v, cur.v};
        f2 u01 = vv * (f2){cur.kd.x, cur.kd.y};
        f2 u23 = vv * (f2){cur.kd.z, cur.kd.w};
        p = dpp_add<0x128>(p); y = dpp_add<0x128>(y);
        p = dpp_add<0x124>(p); y = dpp_add<0x124>(y);
        p = dpp_add<0x122>(p); y = dpp_add<0x122>(y);
        p = dpp_add<0x121>(p); y = dpp_add<0x121>(y);
        f2 pp = {p, p};
        u01 = pp * (f2){cur.bb.x, cur.bb.y} + u01;
        u23 = pp * (f2){cur.bb.z, cur.bb.w} + u23;
        S01 = S01 * (f2){cur.w4.x, cur.w4.y} + u01;
        S23 = S23 * (f2){cur.w4.z, cur.w4.w} + u23;
        if (j == 0) {
          ysel = (cg == 15) ? y : ysel;
          if (c > 0) {
            const int n = (c - 1) * 16 + cg;
            const int t_ = DIR ? (SEQ - 1 - n) : n;
            Y[(tokbase + t_) * 512 + h * 64 + row] = (bf16_t)(pack2(ysel, 0.f) & 0xffffu);
          }
        } else {
          ysel = (cg == j - 1) ? y : ysel;
        }
        rprev = cur.r4;
        q0 = q1;
        q1 = q2;
      }
      __syncthreads();
    }
    {
      f2 qy = S01 * (f2){rprev.x, rprev.y};
      qy = S23 * (f2){rprev.z, rprev.w} + qy;
      float y = qy.x + qy.y;
      y = row16_sum(y);
      ysel = (cg == 15) ? y : ysel;
      const int n = (NCH - 1) * 16 + cg;
      const int t_ = DIR ? (SEQ - 1 - n) : n;
      Y[(tokbase + t_) * 512 + h * 64 + row] = (bf16_t)(pack2(ysel, 0.f) & 0xffffu);
    }
  }
}

constexpr int KLD = 72;
constexpr int VLD = 68;

DI void attn_item(const Params& P, int item, unsigned char* smem, float lam) {
  unsigned char* ws = P.ws;
  const int tid = otid(), lane = tid & 63, wave = tid >> 6;
  const int hh = lane >> 5;
  const int qb = item & 63, h = (item >> 6) & 3, b = item >> 8;
  const int q0 = qb * 128 + wave * 32;
  bf16_t* Ks = (bf16_t*)smem;
  bf16_t* Vs = Ks + 2 * 64 * KLD;
  const bf16_t* Qg = (const bf16_t*)(ws + OFF_Q);
  const bf16_t* Kg = (const bf16_t*)(ws + OFF_K);
  const bf16_t* Vp = (const bf16_t*)(ws + OFF_VT) + (size_t)(b * 4 + h) * 128 * SEQ;
  const float* subln = P.in[21];
  bf16_t* YB = (bf16_t*)(ws + OFF_YB);
#pragma unroll 1
  for (int ci = 0; ci < 2; ++ci) {
    const int hc = h * 2 + (1 - ci);
    const bf16_t* Qp = Qg + ((size_t)(b * 8 + hc) * SEQ + q0 + (lane & 31)) * 64 + hh * 8;
    bf16x8 qf[4];
#pragma unroll
    for (int ks = 0; ks < 4; ++ks) qf[ks] = *(const bf16x8*)(Qp + ks * 16);
    const bf16_t* Kp = Kg + (size_t)(b * 8 + hc) * SEQ * 64;
    f32x16 o[4];
#pragma unroll
    for (int mt = 0; mt < 4; ++mt)
#pragma unroll
      for (int i = 0; i < 16; ++i) o[mt][i] = 0.f;
    float m_run = 0.f, l_run = 0.f;
    uint4 kr0, kr1, vr0, vr1, vr2, vr3;
    const unsigned koff32 = (unsigned)((tid >> 3) * 64 + (tid & 7) * 8);
    const unsigned voff32 = (unsigned)((tid >> 3) * SEQ + (tid & 7) * 8);
    auto glk = [&](int kt) __attribute__((always_inline)) {
      const bf16_t* kb_ = Kp + kt * 4096;
      kr0 = *(const uint4*)(kb_ + koff32);
      kr1 = *(const uint4*)(kb_ + (koff32 + 2048u));
    };
    auto glv = [&](int kt) __attribute__((always_inline)) {
      const bf16_t* vb_ = Vp + kt * 64;
      vr0 = *(const uint4*)(vb_ + voff32);
      vr1 = *(const uint4*)(vb_ + (voff32 + (unsigned)(32 * SEQ)));
      vr2 = *(const uint4*)(vb_ + (voff32 + (unsigned)(64 * SEQ)));
      vr3 = *(const uint4*)(vb_ + (voff32 + (unsigned)(96 * SEQ)));
    };
    const int sw_r = tid >> 3, sw_p = (tid & 7) * 8;
    auto swv = [&](bf16_t* dst, uint4 v) __attribute__((always_inline)) {
      *(uint2*)(dst) = make_uint2(v.x, v.y);
      *(uint2*)(dst + 4) = make_uint2(v.z, v.w);
    };
    auto sw = [&](int buf) __attribute__((always_inline)) {
      bf16_t* kd = Ks + buf * 64 * KLD + sw_r * KLD + sw_p;
      *(uint4*)(kd) = kr0;
      *(uint4*)(kd + 32 * KLD) = kr1;
      bf16_t* vd = Vs + buf * 128 * VLD + sw_r * VLD + sw_p;
      swv(vd, vr0);
      swv(vd + 32 * VLD, vr1);
      swv(vd + 64 * VLD, vr2);
      swv(vd + 96 * VLD, vr3);
    };
    __syncthreads();
    glk(0);
    glv(0);
    sw(0);
    __syncthreads();
#pragma unroll 1
    for (int kt = 0; kt < 128; ++kt) {
      const int buf = kt & 1;
      const bf16_t* kb = Ks + buf * 64 * KLD + (lane & 31) * KLD + hh * 8;
      const bf16x8 ka0 = *(const bf16x8*)(kb + 0), ka1 = *(const bf16x8*)(kb + 16);
      const bf16x8 ka2 = *(const bf16x8*)(kb + 32), ka3 = *(const bf16x8*)(kb + 48);
      if (kt + 1 < 128) glk(kt + 1);
      __builtin_amdgcn_sched_barrier(0);
      f32x16 st0, st1;
      const bf16x8 kc0 = *(const bf16x8*)(kb + 32 * KLD + 0), kc1 = *(const bf16x8*)(kb + 32 * KLD + 16);
      const bf16x8 kc2 = *(const bf16x8*)(kb + 32 * KLD + 32), kc3 = *(const bf16x8*)(kb + 32 * KLD + 48);
      __builtin_amdgcn_sched_barrier(0);
      if (__any(m_run != 0.f)) {
        const float ninit = -m_run;
#pragma unroll
        for (int i = 0; i < 16; ++i) { st0[i] = ninit; st1[i] = ninit; }
        st0 = MFMA32(ka0, qf[0], st0);
        st0 = MFMA32(ka1, qf[1], st0);
        st0 = MFMA32(ka2, qf[2], st0);
        st0 = MFMA32(ka3, qf[3], st0);
        st1 = MFMA32(kc0, qf[0], st1);
        st1 = MFMA32(kc1, qf[1], st1);
        st1 = MFMA32(kc2, qf[2], st1);
        st1 = MFMA32(kc3, qf[3], st1);
      } else {
        f32x16 z;
#pragma unroll
        for (int i = 0; i < 16; ++i) z[i] = 0.f;
        st0 = MFMA32(ka0, qf[0], z);
        st0 = MFMA32(ka1, qf[1], st0);
        st0 = MFMA32(ka2, qf[2], st0);
        st0 = MFMA32(ka3, qf[3], st0);
        st1 = MFMA32(kc0, qf[0], z);
        st1 = MFMA32(kc1, qf[1], st1);
        st1 = MFMA32(kc2, qf[2], st1);
        st1 = MFMA32(kc3, qf[3], st1);
      }
      const bf16_t* vb = Vs + buf * 128 * VLD + (lane & 31) * VLD + hh * 4;
      s16x4 vl0 = *(const s16x4*)(vb + 0 * 32 * VLD), vh0 = *(const s16x4*)(vb + 0 * 32 * VLD + 8);
      s16x4 vl1 = *(const s16x4*)(vb + 1 * 32 * VLD), vh1 = *(const s16x4*)(vb + 1 * 32 * VLD + 8);
      s16x4 vl2 = *(const s16x4*)(vb + 2 * 32 * VLD), vh2 = *(const s16x4*)(vb + 2 * 32 * VLD + 8);
      s16x4 vl3 = *(const s16x4*)(vb + 3 * 32 * VLD), vh3 = *(const s16x4*)(vb + 3 * 32 * VLD + 8);
      if (kt + 1 < 128) glv(kt + 1);
      __builtin_amdgcn_sched_barrier(0);
      float mx = st0[0];
#pragma unroll
      for (int i = 0; i < 16; ++i) { mx = fmaxf(mx, st0[i]); mx = fmaxf(mx, st1[i]); }
      mx = xor32_max(mx);
      const bool first = (kt == 0);
      if (__any(mx > 40.0f) || (first && __any(mx < -40.0f))) {
        const float delta = first ? mx : fmaxf(mx, 0.f);
        const float alpha = first ? 1.0f : __builtin_amdgcn_exp2f(-delta);
        m_run += delta;
        l_run *= alpha;
#pragma unroll
        for (int i = 0; i < 16; ++i) { st0[i] -= delta; st1[i] -= delta; }
#pragma unroll
        for (int mt = 0; mt < 4; ++mt)
#pragma unroll
          for (int i = 0; i < 16; ++i) o[mt][i] *= alpha;
      }
      float ps = 0.f;
#pragma unroll
      for (int i = 0; i < 16; ++i) {
        st0[i] = __builtin_amdgcn_exp2f(st0[i]);
        st1[i] = __builtin_amdgcn_exp2f(st1[i]);
        ps += st0[i] + st1[i];
      }
      l_run += ps;
#pragma unroll
      for (int k4 = 0; k4 < 4; ++k4) {
        const int sub = k4 & 1;
        u32x4 pu;
        if (k4 < 2) {
          pu[0] = pack2(st0[8 * sub + 0], st0[8 * sub + 1]);
          pu[1] = pack2(st0[8 * sub + 2], st0[8 * sub + 3]);
          pu[2] = pack2(st0[8 * sub + 4], st0[8 * sub + 5]);
          pu[3] = pack2(st0[8 * sub + 6], st0[8 * sub + 7]);
        } else {
          pu[0] = pack2(st1[8 * sub + 0], st1[8 * sub + 1]);
          pu[1] = pack2(st1[8 * sub + 2], st1[8 * sub + 3]);
          pu[2] = pack2(st1[8 * sub + 4], st1[8 * sub + 5]);
          pu[3] = pack2(st1[8 * sub + 6], st1[8 * sub + 7]);
        }
        const bf16x8 pfv = __builtin_bit_cast(bf16x8, pu);
        const bf16x8 vf0 = __builtin_shufflevector(vl0, vh0, 0, 1, 2, 3, 4, 5, 6, 7);
        const bf16x8 vf1 = __builtin_shufflevector(vl1, vh1, 0, 1, 2, 3, 4, 5, 6, 7);
        const bf16x8 vf2 = __builtin_shufflevector(vl2, vh2, 0, 1, 2, 3, 4, 5, 6, 7);
        const bf16x8 vf3 = __builtin_shufflevector(vl3, vh3, 0, 1, 2, 3, 4, 5, 6, 7);
        if (k4 < 3) {
          const bf16_t* vn = vb + (k4 + 1) * 16;
          vl0 = *(const s16x4*)(vn + 0 * 32 * VLD); vh0 = *(const s16x4*)(vn + 0 * 32 * VLD + 8);
          vl1 = *(const s16x4*)(vn + 1 * 32 * VLD); vh1 = *(const s16x4*)(vn + 1 * 32 * VLD + 8);
          vl2 = *(const s16x4*)(vn + 2 * 32 * VLD); vh2 = *(const s16x4*)(vn + 2 * 32 * VLD + 8);
          vl3 = *(const s16x4*)(vn + 3 * 32 * VLD); vh3 = *(const s16x4*)(vn + 3 * 32 * VLD + 8);
        }
        __builtin_amdgcn_sched_barrier(0);
        o[0] = MFMA32(vf0, pfv, o[0]);
        o[1] = MFMA32(vf1, pfv, o[1]);
        o[2] = MFMA32(vf2, pfv, o[2]);
        o[3] = MFMA32(vf3, pfv, o[3]);
      }
      if (kt + 1 < 128) sw(buf ^ 1);
      __syncthreads();
    }
    float l = xor32_sum(l_run);
    float inv = 1.0f / l;
    const size_t tok = (size_t)b * SEQ + q0 + (lane & 31);
    if (ci == 0) {
      const float sc = inv * lam;
#pragma unroll
      for (int mt = 0; mt < 4; ++mt)
#pragma unroll
        for (int g = 0; g < 4; ++g) {
          const int dv = 32 * mt + 8 * g + 4 * hh;
          *(uint2*)(YB + tok * 512 + h * 128 + dv) =
              pack4(o[mt][4 * g + 0] * sc, o[mt][4 * g + 1] * sc, o[mt][4 * g + 2] * sc, o[mt][4 * g + 3] * sc);
        }
    } else {
      float ss = 0.f;
#pragma unroll
      for (int mt = 0; mt < 4; ++mt)
#pragma unroll
        for (int g = 0; g < 4; ++g) {
          const int dv = 32 * mt + 8 * g + 4 * hh;
          float4 sv = unpack4(*(const uint2*)(YB + tok * 512 + h * 128 + dv));
          float d0 = o[mt][4 * g + 0] * inv - sv.x, d1 = o[mt][4 * g + 1] * inv - sv.y;
          float d2 = o[mt][4 * g + 2] * inv - sv.z, d3 = o[mt][4 * g + 3] * inv - sv.w;
          o[mt][4 * g + 0] = d0; o[mt][4 * g + 1] = d1; o[mt][4 * g + 2] = d2; o[mt][4 * g + 3] = d3;
          ss += d0 * d0 + d1 * d1 + d2 * d2 + d3 * d3;
        }
      ss = xor32_sum(ss);
      const float rinv = rsqrtf(ss * (1.0f / 128.0f) + 1e-5f) * 0.8f;
#pragma unroll
      for (int mt = 0; mt < 4; ++mt)
#pragma unroll
        for (int g = 0; g < 4; ++g) {
          const int dv = 32 * mt + 8 * g + 4 * hh;
          float4 sw4 = *(const float4*)(subln + dv);
          *(uint2*)(YB + tok * 512 + h * 128 + dv) =
              pack4(o[mt][4 * g + 0] * rinv * sw4.x, o[mt][4 * g + 1] * rinv * sw4.y,
                    o[mt][4 * g + 2] * rinv * sw4.z, o[mt][4 * g + 3] * rinv * sw4.w);
        }
    }
  }
}

DI void phase_mix(const Params& P, unsigned char* smem, int* s_item, int rep = 0, int mode = 3) {
  const int tid = otid();
  if (mode & 1) {
    const bool remap = (gridDim.x == 512);
    for (int sb = blockIdx.x; sb < 256; sb += gridDim.x) {
      const int j = sb >> 3;
      const int si = remap ? ((((sb & 7) * 4 + (j >> 3)) << 3) | (j & 7)) : sb;
      if ((si >> 3) & 1) scan_item<1>(P, si, smem); else scan_item<0>(P, si, smem);
    }
  }
  if (!(mode & 2)) return;
  float a = 0.f, bsum = 0.f;
  {
    const int lane = tid & 63;
    a = P.in[17][lane] * P.in[18][lane];
    bsum = P.in[19][lane] * P.in[20][lane];
    a = wave_sum(a); bsum = wave_sum(bsum);
  }
  const float lam = __expf(a) - __expf(bsum) + 0.2f;
  int* counters = (int*)(P.ws + OFF_SMALL) + 4 * T + rep * 8;
  const int x0 = (int)(xb_xcc_id() & 7u);
  if (tid == 0) s_item[1] = 0;
  for (;;) {
    __syncthreads();
    if (tid == 0) {
      int item = -1;
      int k = s_item[1];
      while (k < 8) {
        const int q = (x0 + k) & 7;
        const int idx = atomicAdd(counters + q, 1);
        if (idx < 64) { item = q * 64 + idx; break; }
        ++k;
      }
      s_item[1] = k;
      s_item[0] = item;
    }
    __syncthreads();
    const int item = __builtin_amdgcn_readfirstlane(*s_item);
    if (item < 0) break;
    attn_item(P, item, smem, lam);
  }
  if (rep == 0) {
    int* tcount = (int*)(P.ws + OFF_SMALL) + 4 * T + 32;
    const float* x = P.in[0];
    bf16_t* H0b = (bf16_t*)P.out + (size_t)T * DM;
    for (;;) {
      __syncthreads();
      if (tid == 0) s_item[0] = atomicAdd(tcount, 1);
      __syncthreads();
      const int l = __builtin_amdgcn_readfirstlane(s_item[0]);
      if (l >= NT_LATE + 256) break;
      if (l < NT_LATE) {
        transpose_late(P, l, (float*)smem);
      } else {
        const size_t base = (size_t)(l - NT_LATE) * 64 * DM;
#pragma unroll 4
        for (int i = 0; i < 64; ++i) {
          const size_t o = base + (size_t)i * DM + tid * 4;
          float4 v = *(const float4*)(x + o);
          *(uint2*)(H0b + o) = pack4(v.x, v.y, v.z, v.w);
        }
      }
    }
  }
}

DI void phase_post(const Params& P, unsigned char* smem) {
  unsigned char* ws = P.ws;
  const int tid = otid();
  const float* Cs = (const float*)smem;
  const bf16_t* Sb = (const bf16_t*)(ws + OFF_S);
  const bf16_t* R = Sb;
  const bf16_t* V = Sb + (size_t)T * 512;
  const bf16_t* KD0 = Sb + (size_t)5 * T * 512;
  const bf16_t* KD1 = Sb + (size_t)6 * T * 512;
  const bf16_t* Y0 = (const bf16_t*)P.out;
  const bf16_t* Y1 = (const bf16_t*)P.out + (size_t)T * 512;
  const float* ln_w = P.in[14];
  const float* ln_b = P.in[15];
  const float* r_k = P.in[13];
  bf16_t* YA = (bf16_t*)(ws + OFF_YA);
  const bf16_t* AGD = (const bf16_t*)(ws + OFF_AGD);
  const bf16_t* G2T = (const bf16_t*)(ws + OFF_G2T);
  for (int item = blockIdx.x; item < 128 * 4; item += gridDim.x) {
    const int nt = item & 3, mt = item >> 2;
    const int m0 = mt * 128;
    f32x16 acc[2][2];
    zero_acc(acc);
    gemm_tile<false>(acc, AGD, 128, G2T + (size_t)nt * 128 * 128, 128, 128, m0, smem);
    stage_acc(acc, smem);
    const int gidx = tid >> 4, l16 = tid & 15;
#pragma unroll 2
    for (int it = 0; it < 16; ++it) {
      const int pair = gidx + 16 * it;
      const int row = pair >> 1, hsel = pair & 1;
      const int cl = hsel * 64 + l16 * 4;
      const int c = nt * 128 + cl;
      const size_t off = (size_t)(m0 + row) * 512 + c;
      float4 y0 = unpack4(*(const uint2*)(Y0 + off));
      float4 y1 = unpack4(*(const uint2*)(Y1 + off));
      float4 y = make_float4(y0.x + y1.x, y0.y + y1.y, y0.z + y1.z, y0.w + y1.w);
      float sm = y.x + y.y + y.z + y.w;
      sm = row16_sum(sm);
      const float mean = sm * (1.0f / 64.0f);
      y.x -= mean; y.y -= mean; y.z -= mean; y.w -= mean;
      float vs = y.x * y.x + y.y * y.y + y.z * y.z + y.w * y.w;
      vs = row16_sum(vs);
      const float rstd = rsqrtf(vs * (1.0f / 64.0f) + 64e-5f);
      float4 lw = *(const float4*)(ln_w + c);
      float4 lb = *(const float4*)(ln_b + c);
      float4 r = unpack4(*(const uint2*)(R + off));
      float4 k0 = unpack4(*(const uint2*)(KD0 + off));
      float4 k1 = unpack4(*(const uint2*)(KD1 + off));
      float4 v = unpack4(*(const uint2*)(V + off));
      float4 rk = *(const float4*)(r_k + c);
      float dt = r.x * (k0.x + k1.x) * rk.x + r.y * (k0.y + k1.y) * rk.y + r.z * (k0.z + k1.z) * rk.z + r.w * (k0.w + k1.w) * rk.w;
      dt = row16_sum(dt);
      float4 g = *(const float4*)(Cs + row * LDC + cl);
      float ox = (y.x * rstd * lw.x + lb.x + dt * v.x) * g.x;
      float oy = (y.y * rstd * lw.y + lb.y + dt * v.y) * g.y;
      float oz = (y.z * rstd * lw.z + lb.z + dt * v.z) * g.z;
      float ow = (y.w * rstd * lw.w + lb.w + dt * v.w) * g.w;
      *(uint2*)(YA + off) = pack4(ox, oy, oz, ow);
    }
  }
}

template <int HALF>
DI void wo_half(const Params& P, unsigned char* smem, float* rs_tile) {
  unsigned char* ws = P.ws;
  const int tid = otid(), lane = tid & 63, wave = tid >> 6;
  const float* Cs = (const float*)smem;
  const float* rstd0 = (const float*)(ws + OFF_SMALL);
  bf16_t* MG = (bf16_t*)(ws + OFF_MERGED);
  bf16_t* PART = (bf16_t*)(ws + OFF_HFF);
  const bf16_t* H0 = (const bf16_t*)P.out + (size_t)T * DM;
  const bf16_t* WinT = (const bf16_t*)(ws + OFF_WIN);
  const bf16_t* Yin = (const bf16_t*)(ws + (HALF ? OFF_YB : OFF_YA));
  const bf16_t* Wo = (const bf16_t*)(ws + (HALF ? OFF_WOB : OFF_WOA));
  const bool xmap = (gridDim.x == 512);
#pragma unroll 1
  for (int tile = blockIdx.x; tile < 128 * 8; tile += gridDim.x) {
    int nt = tile & 7, mt = tile >> 3;
    if (xmap) { const int x = tile & 7, j = tile >> 3, q = j & 63; nt = q >> 3; mt = x * 16 + (j >> 6) * 8 + (q & 7); }
    const int m0 = mt * 128, n0 = nt * 128;
    unsigned gp[2][2][8];
    {
      f32x16 accg[2][2];
      zero_acc(accg);
      gemm_tile<false, 0, false>(accg, H0, DM, WinT + (size_t)((HALF ? 4480 : 3456) + n0) * DM, DM, DM, m0, smem);
      const int wm = wave >> 1, hh = lane >> 5;
      if (tid < 128) rs_tile[tid] = rstd0[m0 + tid];
      __syncthreads();
      const float* rsp = rs_tile + wm * 64 + 4 * hh;
#pragma unroll
      for (int mi = 0; mi < 2; ++mi)
#pragma unroll
        for (int ni = 0; ni < 2; ++ni)
#pragma unroll
          for (int i = 0; i < 16; i += 2) {
            const float rs0 = rsp[mi * 32 + (i & 3) + 8 * (i >> 2)];
            const float rs1 = rsp[mi * 32 + ((i + 1) & 3) + 8 * ((i + 1) >> 2)];
            gp[mi][ni][i >> 1] = pack2(sigmoidf_(rs0 * accg[mi][ni][i]), sigmoidf_(rs1 * accg[mi][ni][i + 1]));
          }
    }
    f32x16 accv[2][2];
    zero_acc(accv);
    gemm_tile<false, 0, false>(accv, Yin, 512, Wo + (size_t)n0 * 512, 512, 512, m0, smem);
#pragma unroll
    for (int mi = 0; mi < 2; ++mi)
#pragma unroll
      for (int ni = 0; ni < 2; ++ni)
#pragma unroll
        for (int i = 0; i < 16; i += 2) {
          const unsigned g = gp[mi][ni][i >> 1];
          accv[mi][ni][i] *= bf2f(g & 0xffffu);
          accv[mi][ni][i + 1] *= bf2f(g >> 16);
        }
    stage_acc(accv, smem);
#pragma unroll 2
    for (int it = 0; it < 16; ++it) {
      int idx = tid + 256 * it, row = idx >> 5, c4 = (idx & 31) * 4;
      const size_t off = (size_t)(m0 + row) * DM + n0 + c4;
      float4 c = *(const float4*)(Cs + row * LDC + c4);
      if (HALF == 0) {
        *(uint2*)(PART + off) = pack4(c.x, c.y, c.z, c.w);
      } else {
        float4 a = unpack4(*(const uint2*)(PART + off));
        *(uint2*)(MG + off) = pack4(a.x + c.x, a.y + c.y, a.z + c.z, a.w + c.w);
      }
    }
  }
}
DI void phase_wo(const Params& P, unsigned char* smem, float* rs_tile) {
  wo_half<0>(P, smem, rs_tile);
  wo_half<1>(P, smem, rs_tile);
}

DI void resid_epilogue(const float* Cs, const float* xi, float* xo, bf16_t* xb, float* ss, int m0, int n0, bool write_xb, const float* mul = nullptr) {
  const int tid = otid();
#pragma unroll 4
  for (int it = 0; it < 16; ++it) {
    int idx = tid + 256 * it, row = idx >> 5, c4 = (idx & 31) * 4;
    size_t off = (size_t)(m0 + row) * DM + n0 + c4;
    float4 a = *(const float4*)(xi + off);
    float4 c = *(const float4*)(Cs + row * LDC + c4);
    if (mul) { float4 g = *(const float4*)(mul + off); c.x *= g.x; c.y *= g.y; c.z *= g.z; c.w *= g.w; }
    float4 o = make_float4(a.x + c.x, a.y + c.y, a.z + c.z, a.w + c.w);
    *(float4*)(xo + off) = o;
    if (write_xb) *(uint2*)(xb + off) = pack4(o.x, o.y, o.z, o.w);
    float s = o.x * o.x + o.y * o.y + o.z * o.z + o.w * o.w;
    s = half32_sum(s);
    if ((tid & 31) == 0) atomicAdd(ss + m0 + row, s);
  }
}

DI void phase_wout(const Params& P, unsigned char* smem) {
  unsigned char* ws = P.ws;
  const float* Cs = (const float*)smem;
  float* small = (float*)(ws + OFF_SMALL);
  const bf16_t* MG = (const bf16_t*)(ws + OFF_MERGED);
  const bf16_t* WoutT = (const bf16_t*)(ws + OFF_WOUT);
  const bool xmap = (gridDim.x == 512);
#pragma unroll 1
  for (int tile = blockIdx.x; tile < 64 * 8; tile += gridDim.x) {
    int nt = tile & 7, mt = tile >> 3;
    if (xmap) { const int x = tile & 7, j = tile >> 3; nt = j >> 3; mt = x * 8 + (j & 7); }
    const int m0 = mt * 256, n0 = nt * 128;
    f32x16 acc[4][2];
    zero_acc256(acc);
    gemm_tile256(acc, MG, DM, WoutT + (size_t)n0 * DM, DM, DM, m0, smem);
#pragma unroll 1
    for (int hsel = 0; hsel < 2; ++hsel) {
      stage_half(acc, hsel, smem);
      resid_epilogue(Cs, P.in[0], P.out, (bf16_t*)(ws + OFF_XB), small + T, m0 + hsel * 128, n0, true);
      __syncthreads();
    }
  }
}

DI void phase_ff1(const Params& P, unsigned char* smem) {
  unsigned char* ws = P.ws;
  const int tid = otid();
  const float* Cs = (const float*)smem;
  const float* ss1 = (const float*)(ws + OFF_SMALL) + T;
  const bf16_t* XB = (const bf16_t*)(ws + OFF_XB);
  const bf16_t* W1T = (const bf16_t*)(ws + OFF_W1);
  bf16_t* HFF = (bf16_t*)(ws + OFF_HFF);
  const bool xmap = (gridDim.x == 512);
#pragma unroll 1
  for (int tile = blockIdx.x; tile < 64 * 32; tile += gridDim.x) {
    int nt = tile & 31, mt = tile >> 5;
    if (xmap) { const int x = tile & 7, j = tile >> 3, q = j & 63; nt = (j >> 6) * 8 + (q >> 3); mt = x * 8 + (q & 7); }
    const int m0 = mt * 256, n0 = nt * 128;
    f32x16 acc[4][2];
    zero_acc256(acc);
    gemm_tile256(acc, XB, DM, W1T + (size_t)n0 * DM, DM, DM, m0, smem);
#pragma unroll 1
    for (int hsel = 0; hsel < 2; ++hsel) {
      stage_half(acc, hsel, smem);
      const int mh = m0 + hsel * 128;
#pragma unroll 4
      for (int it = 0; it < 16; ++it) {
        int idx = tid + 256 * it, row = idx >> 5, c4 = (idx & 31) * 4;
        float rs = rsqrtf(ss1[mh + row] * (1.0f / 1024.0f) + 1e-6f);
        float4 c = *(const float4*)(Cs + row * LDC + c4);
        float hx = fmaxf(c.x * rs, 0.f), hy = fmaxf(c.y * rs, 0.f), hz = fmaxf(c.z * rs, 0.f), hw = fmaxf(c.w * rs, 0.f);
        *(uint2*)(HFF + (size_t)(mh + row) * 4096 + n0 + c4) = pack4(hx * hx, hy * hy, hz * hz, hw * hw);
      }
      __syncthreads();
    }
  }
}

DI void phase_ff2(const Params& P, unsigned char* smem) {
  unsigned char* ws = P.ws;
  const float* Cs = (const float*)smem;
  float* small = (float*)(ws + OFF_SMALL);
  const bf16_t* HFF = (const bf16_t*)(ws + OFF_HFF);
  const bf16_t* W2T = (const bf16_t*)(ws + OFF_W2F);
  const bool xmap = (gridDim.x == 512);
#pragma unroll 1
  for (int tile = blockIdx.x; tile < 64 * 8; tile += gridDim.x) {
    int nt = tile & 7, mt = tile >> 3;
    if (xmap) { const int x = tile & 7, j = tile >> 3; nt = j >> 3; mt = x * 8 + (j & 7); }
    const int m0 = mt * 256, n0 = nt * 128;
    f32x16 acc[4][2];
    zero_acc256(acc);
    gemm_tile256(acc, HFF, 4096, W2T + (size_t)n0 * 4096, 4096, 4096, m0, smem);
#pragma unroll 1
    for (int hsel = 0; hsel < 2; ++hsel) {
      stage_half(acc, hsel, smem);
      resid_epilogue(Cs, P.out, P.out, (bf16_t*)(ws + OFF_XB), small + 2 * T, m0 + hsel * 128, n0, true);
      __syncthreads();
    }
  }
}

DI void phase_ple(const Params& P, unsigned char* smem, float* rs_tile) {
  unsigned char* ws = P.ws;
  const int tid = otid(), lane = tid & 63, wave = tid >> 6;
  const float* Cs = (const float*)smem;
  float* small = (float*)(ws + OFF_SMALL);
  const bf16_t* XB = (const bf16_t*)(ws + OFF_XB);
  const bf16_t* WpgT = (const bf16_t*)(ws + OFF_WPG);
  const bf16_t* WppT = (const bf16_t*)(ws + OFF_WPP);
  const float* ss2 = small + 2 * T;
  const bool xmap = (gridDim.x == 512);
#pragma unroll 1
  for (int tile = blockIdx.x; tile < 128 * 8; tile += gridDim.x) {
    int nt = tile & 7, mt = tile >> 3;
    if (xmap) { const int x = tile & 7, j = tile >> 3, q = j & 63; nt = q >> 3; mt = x * 16 + (j >> 6) * 8 + (q & 7); }
    const int m0 = mt * 128, n0 = nt * 128;
    unsigned gp[2][2][8];
    {
      f32x16 accg[2][2];
      zero_acc(accg);
      gemm_tile<false, 0, false>(accg, XB, DM, WpgT + (size_t)n0 * DM, DM, DM, m0, smem);
      const int wm = wave >> 1, hh = lane >> 5;
      if (tid < 128) rs_tile[tid] = rsqrtf(ss2[m0 + tid] * (1.0f / 1024.0f) + 1e-6f);
      __syncthreads();
      const float* rsp = rs_tile + wm * 64 + 4 * hh;
#pragma unroll
      for (int mi = 0; mi < 2; ++mi)
#pragma unroll
        for (int ni = 0; ni < 2; ++ni)
#pragma unroll
          for (int i = 0; i < 16; i += 2) {
            const float rs0 = rsp[mi * 32 + (i & 3) + 8 * (i >> 2)];
            const float rs1 = rsp[mi * 32 + ((i + 1) & 3) + 8 * ((i + 1) >> 2)];
            gp[mi][ni][i >> 1] = pack2(sigmoidf_(rs0 * accg[mi][ni][i]), sigmoidf_(rs1 * accg[mi][ni][i + 1]));
          }
    }
    f32x16 accv[2][2];
    zero_acc(accv);
    gemm_tile<true>(accv, P.in[1], 256, WppT + (size_t)n0 * 256, 256, 256, m0, smem);
#pragma unroll
    for (int mi = 0; mi < 2; ++mi)
#pragma unroll
      for (int ni = 0; ni < 2; ++ni)
#pragma unroll
        for (int i = 0; i < 16; i += 2) {
          const unsigned g = gp[mi][ni][i >> 1];
          accv[mi][ni][i] *= bf2f(g & 0xffffu);
          accv[mi][ni][i + 1] *= bf2f(g >> 16);
        }
    stage_acc(accv, smem);
    resid_epilogue(Cs, P.out, P.out, nullptr, small + 3 * T, m0, n0, false);
  }
}

DI void phase_final(const Params& P) {
  const float* ss3 = (const float*)(P.ws + OFF_SMALL) + 3 * T;
  const float* g = P.in[30];
  const size_t n4 = (size_t)T * DM / 4;
  for (size_t i = (size_t)blockIdx.x * NTHREADS + threadIdx.x; i < n4; i += (size_t)gridDim.x * NTHREADS) {
    const int row = (int)(i >> 8);
    const int c = (int)(i & 255) * 4;
    const float rs = rsqrtf(ss3[row] * (1.0f / 1024.0f) + 1e-6f);
    float4 v = *(const float4*)(P.out + i * 4);
    float4 gg = *(const float4*)(g + c);
    v.x *= rs * gg.x; v.y *= rs * gg.y; v.z *= rs * gg.z; v.w *= rs * gg.w;
    *(float4*)(P.out + i * 4) = v;
  }
}

#define XB_TMO      128
#define XB_XCNT(j)  (256  + 64 * (j))
#define XB_XSUB(j)  (1280 + 64 * (j))
#define XB_XGEN(j)  (2304 + 64 * (j))
#define XB_TOP      3328
#define XB_TOPGEN   3392
#define XCD_BAR_WORDS 3456
#define XB_SPIN_CAP (1u << 20)
#define LAS __attribute__((address_space(3)))
constexpr size_t OFF_BAR = OFF_SMALL + 524288;

DI unsigned xb_ld(unsigned* p) { return __hip_atomic_load(p, __ATOMIC_RELAXED, __HIP_MEMORY_SCOPE_AGENT); }
DI unsigned xb_add(unsigned* p, unsigned v) { return __hip_atomic_fetch_add(p, v, __ATOMIC_RELAXED, __HIP_MEMORY_SCOPE_AGENT); }
DI unsigned xb_xcc_id() { return (unsigned)__builtin_amdgcn_s_getreg((3 << 11) | 20) & 0xFu; }
#define XB_SPIN(cond, bar) do { unsigned _sp = 0; while (cond) { __builtin_amdgcn_s_sleep(1); \
    if ((++_sp & 255u) == 0u) { if (xb_ld(&(bar)[XB_TMO])) break; if (_sp > XB_SPIN_CAP) { atomicAdd(&(bar)[XB_TMO], 1u); break; } } } } while (0)

struct XcdBarrier { unsigned* bar; unsigned x; volatile unsigned* st; };

DI XcdBarrier xcd_barrier_post(unsigned* bar, volatile unsigned* st) {
  XcdBarrier b; b.bar = bar; b.x = xb_xcc_id(); b.st = st;
  if (threadIdx.x == 0) (void)xb_add(&bar[XB_XCNT(b.x)], 1u);
  return b;
}
DI void xcd_barrier_complete(unsigned* bar, unsigned x, unsigned& nloc, unsigned& nx) {
  const unsigned G = gridDim.x * gridDim.y * gridDim.z;
  unsigned sum, cnt, mine, sp = 0u;
  for (;;) {
    sum = 0u; cnt = 0u; mine = 0u;
#pragma unroll
    for (unsigned j = 0; j < 16; ++j) { const unsigned c = xb_ld(&bar[XB_XCNT(j)]); sum += c; cnt += (c > 0u) ? 1u : 0u; mine = (j == x) ? c : mine; }
    if (sum == G) break;
    __builtin_amdgcn_s_sleep(1);
    if ((++sp & 255u) == 0u) { if (xb_ld(&bar[XB_TMO])) break; if (sp > XB_SPIN_CAP) { atomicAdd(&bar[XB_TMO], 1u); break; } }
  }
  nloc = mine > 0u ? mine : 1u; nx = cnt > 0u ? cnt : 1u;
}
DI void xcd_barrier(const XcdBarrier& b) {
  asm volatile("s_waitcnt vmcnt(0)" ::: "memory");
  __syncthreads();
  if (threadIdx.x == 0) {
    unsigned* bar = b.bar;
    __builtin_amdgcn_s_waitcnt(0);
    unsigned nloc = b.st[0], nx = b.st[1];
    if (nloc == 0u) { xcd_barrier_complete(bar, b.x, nloc, nx); b.st[0] = nloc; b.st[1] = nx; }
    const unsigned old = xb_add(&bar[XB_XSUB(b.x)], 1u);
    const unsigned gen = old / nloc;
    if (old + 1u == (gen + 1u) * nloc) {
      __builtin_amdgcn_fence(__ATOMIC_RELEASE, "agent");
      asm volatile("s_waitcnt vmcnt(0)" ::: "memory");
      const unsigned og = xb_add(&bar[XB_TOP], 1u);
      const unsigned tg = og / nx;
      if (og + 1u == (tg + 1u) * nx) xb_add(&bar[XB_TOPGEN], 1u);
      else XB_SPIN(xb_ld(&bar[XB_TOPGEN]) == tg, bar);
      __builtin_amdgcn_fence(__ATOMIC_ACQUIRE, "agent");
      xb_add(&bar[XB_XGEN(b.x)], 1u);
      asm volatile("s_waitcnt vmcnt(0)" ::: "memory");
    } else {
      XB_SPIN(xb_ld(&bar[XB_XGEN(b.x)]) == gen, bar);
      __builtin_amdgcn_fence(__ATOMIC_ACQUIRE, "agent");
      asm volatile("s_waitcnt vmcnt(0)" ::: "memory");
    }
  }
  __syncthreads();
}

__global__ void __launch_bounds__(NTHREADS, 2) fwd_megakernel(Params P) {
  __shared__ __attribute__((aligned(16))) unsigned char smem[SMEM_BYTES];
  __shared__ int s_item[2];
  __shared__ float rs_tile[128];
  __shared__ uint4 xb_words;
  cg::grid_group grid = cg::this_grid();
  if (P.ws == nullptr) grid.sync();
  if (threadIdx.x == 0) xb_words = make_uint4(0u, 0u, 0u, 0u);
  __syncthreads();
  const XcdBarrier xb = xcd_barrier_post((unsigned*)(P.ws + OFF_BAR), (volatile unsigned*)&xb_words);
  phase_prep(P, smem);
  xcd_barrier(xb);
  phase_p1(P, smem);
  xcd_barrier(xb);
  phase_e1(P);
  xcd_barrier(xb);
  phase_lora(P, smem);
  xcd_barrier(xb);
  phase_mix(P, smem, s_item);
  xcd_barrier(xb);
  phase_post(P, smem);
  xcd_barrier(xb);
  phase_wo(P, smem, rs_tile);
  xcd_barrier(xb);
  phase_wout(P, smem);
  xcd_barrier(xb);
  phase_ff1(P, smem);
  xcd_barrier(xb);
  phase_ff2(P, smem);
  xcd_barrier(xb);
  phase_ple(P, smem, rs_tile);
  xcd_barrier(xb);
  phase_final(P);
}

extern "C" void kernel_launch(void* const* d_in, const int* in_sizes, int n_in, void* d_out, int out_size,
                              void* d_ws, size_t ws_size, hipStream_t stream) {
  static int grid_blocks = 0;
  if (!grid_blocks) {
    int dev = 0, cus = 0, per_cu = 0;
    hipGetDevice(&dev);
    hipDeviceGetAttribute(&cus, hipDeviceAttributeMultiprocessorCount, dev);
    hipOccupancyMaxActiveBlocksPerMultiprocessor(&per_cu, fwd_megakernel, NTHREADS, 0);
    if (per_cu > 2) per_cu = 2;
    if (per_cu < 1) per_cu = 1;
    grid_blocks = cus * per_cu;
  }
  Params p{};
  for (int i = 0; i < 31; ++i) p.in[i] = (const float*)d_in[i];
  p.out = (float*)d_out;
  p.ws = (unsigned char*)d_ws;
  hipMemsetAsync((unsigned char*)d_ws + OFF_BAR, 0, XCD_BAR_WORDS * sizeof(unsigned), stream);
  void* args[] = {&p};
  hipError_t e = hipLaunchCooperativeKernel((void*)fwd_megakernel, dim3(grid_blocks), dim3(NTHREADS), args, 0, stream);
  if (e != hipSuccess) fprintf(stderr, "cooperative launch failed: %s (grid %d)\n", hipGetErrorString(e), grid_blocks);
}
```

```cpp
#include <hip/hip_runtime.h>
#include <hip/hip_cooperative_groups.h>
#include <cstdio>
namespace cg = cooperative_groups;

#define DI __device__ __forceinline__
typedef __attribute__((ext_vector_type(8))) short bf16x8;
typedef __attribute__((ext_vector_type(4))) short s16x4;
typedef __attribute__((ext_vector_type(16))) float f32x16;
typedef unsigned short bf16_t;
typedef unsigned u32x4 __attribute__((ext_vector_type(4)));

#define MFMA32(a, b, c) __builtin_amdgcn_mfma_f32_32x32x16_bf16((a), (b), (c), 0, 0, 0)

constexpr int T = 16384;
constexpr int SEQ = 8192;
constexpr int DM = 1024;
constexpr int NTHREADS = 256;

constexpr size_t OFF_WIN = 0;
constexpr size_t OFF_W1 = 11272192;
constexpr size_t OFF_W2F = 19660800;
constexpr size_t OFF_WOUT = 28049408;
constexpr size_t OFF_WPG = 30146560;
constexpr size_t OFF_WPP = 32243712;
constexpr size_t OFF_WOA = 32768000;
constexpr size_t OFF_WOB = 33816576;
constexpr size_t OFF_W2T = 34865152;
constexpr size_t OFF_A2T = 34996224;
constexpr size_t OFF_G2T = 35127296;
constexpr size_t OFF_SMALL = 35258368;
constexpr size_t OFF_S = 36306944;
constexpr size_t SLOT = 16777216;
constexpr size_t OFF_Q = 187301888;
constexpr size_t OFF_K = 204079104;
constexpr size_t OFF_VT = 220856320;
constexpr size_t OFF_AWD = 237633536;
constexpr size_t OFF_AAD = 241827840;
constexpr size_t OFF_AGD = 246022144;
constexpr size_t OFF_YB = 250216448;
constexpr size_t OFF_KTMP = OFF_YB;
constexpr size_t OFF_YA = OFF_Q;
constexpr size_t OFF_MERGED = OFF_K;
constexpr size_t OFF_XB = OFF_S;
constexpr size_t OFF_HFF = OFF_S + 33554432;
constexpr size_t OFF_H0 = OFF_S + 7 * SLOT;

struct Params {
  const float* in[31];
  float* out;
  unsigned char* ws;
};

DI bf16_t f2bf(float x) {
  unsigned u = __float_as_uint(x);
  u += 0x7fffu + ((u >> 16) & 1u);
  return (bf16_t)(u >> 16);
}
DI float bf2f(unsigned b) { return __uint_as_float(b << 16); }
typedef __bf16 bf16x2v __attribute__((ext_vector_type(2)));
typedef float f32x2v __attribute__((ext_vector_type(2)));
DI unsigned pack2(float a, float b) {
  f32x2v f = {a, b};
  bf16x2v r = __builtin_convertvector(f, bf16x2v);
  return __builtin_bit_cast(unsigned, r);
}
DI uint2 pack4(float a, float b, float c, float d) { return make_uint2(pack2(a, b), pack2(c, d)); }
DI float4 unpack4(uint2 v) {
  return make_float4(bf2f(v.x & 0xffffu), bf2f(v.x >> 16), bf2f(v.y & 0xffffu), bf2f(v.y >> 16));
}
DI float sigmoidf_(float x) { return 1.0f / (1.0f + __expf(-x)); }
DI unsigned xb_xcc_id();
DI int otid() { int t = threadIdx.x; asm volatile("" : "+v"(t)); return t; }
DI int crow(int i, int hh) { return (i & 3) + 8 * (i >> 2) + 4 * hh; }

template <int CTRL>
DI float dpp_add(float p) {
  int q = __builtin_amdgcn_update_dpp(0, __float_as_int(p), CTRL, 0xf, 0xf, false);
  return p + __int_as_float(q);
}
DI float row16_sum(float p) {
  p = dpp_add<0x128>(p);
  p = dpp_add<0x124>(p);
  p = dpp_add<0x122>(p);
  p = dpp_add<0x121>(p);
  return p;
}
DI float xor32_sum(float v) {
  auto r = __builtin_amdgcn_permlane32_swap(__float_as_uint(v), __float_as_uint(v), false, false);
  return __uint_as_float(r[0]) + __uint_as_float(r[1]);
}
DI float xor32_max(float v) {
  auto r = __builtin_amdgcn_permlane32_swap(__float_as_uint(v), __float_as_uint(v), false, false);
  return fmaxf(__uint_as_float(r[0]), __uint_as_float(r[1]));
}
DI float half32_sum(float v) {
  v = row16_sum(v);
  auto r = __builtin_amdgcn_permlane16_swap(__float_as_uint(v), __float_as_uint(v), false, false);
  return __uint_as_float(r[0]) + __uint_as_float(r[1]);
}
DI float wave_sum(float v) { return xor32_sum(half32_sum(v)); }

constexpr int LDT = 72;
constexpr int LDC = 132;
constexpr int SMEM_BYTES = 2 * 2 * 128 * LDT * 2;

template <bool AF32, int PROBE = 0, bool PF2 = true>
DI void gemm_tile(f32x16 (&acc)[2][2], const void* __restrict__ Aptr, int lda,
                  const bf16_t* __restrict__ Bt, int ldb, int K, int m0, unsigned char* smem) {
  const int tid = otid(), lane = tid & 63, wave = tid >> 6;
  const int wm = wave >> 1, wn = wave & 1;
  bf16_t* As = (bf16_t*)smem;
  bf16_t* Bs = As + 2 * 128 * LDT;
  const int nk = K >> 6;
  const bf16_t* A16 = (const bf16_t*)Aptr;
  const float* A32 = (const float*)Aptr;
  const unsigned aoff32 = AF32 ? (unsigned)((tid >> 4) * lda + (tid & 15) * 4) : (unsigned)((tid >> 3) * lda + (tid & 7) * 8);
  const unsigned boff32 = (unsigned)((tid >> 3) * ldb + (tid & 7) * 8);
  const float* A32b = A32 + (size_t)m0 * lda;
  const bf16_t* A16b = A16 + (size_t)m0 * lda;
#define GL32(p, kt_) { \
    const float* ab_ = A32b + (kt_) * 64; \
    p##f0 = *(const float4*)((ab_ + 0 * 16 * lda) + aoff32); \
    p##f1 = *(const float4*)((ab_ + 1 * 16 * lda) + aoff32); \
    p##f2 = *(const float4*)((ab_ + 2 * 16 * lda) + aoff32); \
    p##f3 = *(const float4*)((ab_ + 3 * 16 * lda) + aoff32); \
    p##f4 = *(const float4*)((ab_ + 4 * 16 * lda) + aoff32); \
    p##f5 = *(const float4*)((ab_ + 5 * 16 * lda) + aoff32); \
    p##f6 = *(const float4*)((ab_ + 6 * 16 * lda) + aoff32); \
    p##f7 = *(const float4*)((ab_ + 7 * 16 * lda) + aoff32); \
    const bf16_t* bb_ = Bt + (kt_) * 64; \
    p##b0 = *(const uint4*)((bb_ + 0 * 32 * ldb) + boff32); \
    p##b1 = *(const uint4*)((bb_ + 1 * 32 * ldb) + boff32); \
    p##b2 = *(const uint4*)((bb_ + 2 * 32 * ldb) + boff32); \
    p##b3 = *(const uint4*)((bb_ + 3 * 32 * ldb) + boff32); }
#define GL16(p, kt_) { \
    const bf16_t* ab_ = A16b + (kt_) * 64; \
    p##a0 = *(const uint4*)((ab_ + 0 * 32 * lda) + aoff32); \
    p##a1 = *(const uint4*)((ab_ + 1 * 32 * lda) + aoff32); \
    p##a2 = *(const uint4*)((ab_ + 2 * 32 * lda) + aoff32); \
    p##a3 = *(const uint4*)((ab_ + 3 * 32 * lda) + aoff32); \
    const bf16_t* bb_ = Bt + (kt_) * 64; \
    p##b0 = *(const uint4*)((bb_ + 0 * 32 * ldb) + boff32); \
    p##b1 = *(const uint4*)((bb_ + 1 * 32 * ldb) + boff32); \
    p##b2 = *(const uint4*)((bb_ + 2 * 32 * ldb) + boff32); \
    p##b3 = *(const uint4*)((bb_ + 3 * 32 * ldb) + boff32); }
#define SW32(p, buf_) { \
    bf16_t* d_ = As + (buf_) * 128 * LDT + (tid >> 4) * LDT + (tid & 15) * 4; \
    *(uint2*)(d_ + 0 * 16 * LDT) = pack4(p##f0.x, p##f0.y, p##f0.z, p##f0.w); \
    *(uint2*)(d_ + 1 * 16 * LDT) = pack4(p##f1.x, p##f1.y, p##f1.z, p##f1.w); \
    *(uint2*)(d_ + 2 * 16 * LDT) = pack4(p##f2.x, p##f2.y, p##f2.z, p##f2.w); \
    *(uint2*)(d_ + 3 * 16 * LDT) = pack4(p##f3.x, p##f3.y, p##f3.z, p##f3.w); \
    *(uint2*)(d_ + 4 * 16 * LDT) = pack4(p##f4.x, p##f4.y, p##f4.z, p##f4.w); \
    *(uint2*)(d_ + 5 * 16 * LDT) = pack4(p##f5.x, p##f5.y, p##f5.z, p##f5.w); \
    *(uint2*)(d_ + 6 * 16 * LDT) = pack4(p##f6.x, p##f6.y, p##f6.z, p##f6.w); \
    *(uint2*)(d_ + 7 * 16 * LDT) = pack4(p##f7.x, p##f7.y, p##f7.z, p##f7.w); \
    bf16_t* d2_ = Bs + (buf_) * 128 * LDT + (tid >> 3) * LDT + (tid & 7) * 8; \
    *(uint4*)(d2_ + 0 * 32 * LDT) = p##b0; *(uint4*)(d2_ + 1 * 32 * LDT) = p##b1; \
    *(uint4*)(d2_ + 2 * 32 * LDT) = p##b2; *(uint4*)(d2_ + 3 * 32 * LDT) = p##b3; }
#define SW16(p, buf_) { \
    bf16_t* d_ = As + (buf_) * 128 * LDT + (tid >> 3) * LDT + (tid & 7) * 8; \
    *(uint4*)(d_ + 0 * 32 * LDT) = p##a0; *(uint4*)(d_ + 1 * 32 * LDT) = p##a1; \
    *(uint4*)(d_ + 2 * 32 * LDT) = p##a2; *(uint4*)(d_ + 3 * 32 * LDT) = p##a3; \
    bf16_t* d2_ = Bs + (buf_) * 128 * LDT + (tid >> 3) * LDT + (tid & 7) * 8; \
    *(uint4*)(d2_ + 0 * 32 * LDT) = p##b0; *(uint4*)(d2_ + 1 * 32 * LDT) = p##b1; \
    *(uint4*)(d2_ + 2 * 32 * LDT) = p##b2; *(uint4*)(d2_ + 3 * 32 * LDT) = p##b3; }
  auto compute = [&](int buf) __attribute__((always_inline)) {
    const bf16_t* as = As + buf * 128 * LDT + (wm * 64 + (lane & 31)) * LDT + (lane >> 5) * 8;
    const bf16_t* bs = Bs + buf * 128 * LDT + (wn * 64 + (lane & 31)) * LDT + (lane >> 5) * 8;
#pragma unroll
    for (int ks = 0; ks < 4; ++ks) {
      bf16x8 a0 = *(const bf16x8*)(as + ks * 16);
      bf16x8 a1 = *(const bf16x8*)(as + 32 * LDT + ks * 16);
      bf16x8 b0 = *(const bf16x8*)(bs + ks * 16);
      bf16x8 b1 = *(const bf16x8*)(bs + 32 * LDT + ks * 16);
      acc[0][0] = MFMA32(a0, b0, acc[0][0]);
      acc[0][1] = MFMA32(a0, b1, acc[0][1]);
      acc[1][0] = MFMA32(a1, b0, acc[1][0]);
      acc[1][1] = MFMA32(a1, b1, acc[1][1]);
    }
  };
  __syncthreads();
  if (AF32) {
    float4 sf0, sf1, sf2, sf3, sf4, sf5, sf6, sf7;
    uint4 sb0, sb1, sb2, sb3;
    GL32(s, 0);
    SW32(s, 0);
    __syncthreads();
#pragma unroll 1
    for (int kt = 0; kt < nk - 1; ++kt) {
      const int buf = kt & 1;
      GL32(s, kt + 1);
      __builtin_amdgcn_sched_barrier(0);
      compute(buf);
      SW32(s, buf ^ 1);
      __syncthreads();
    }
    compute((nk - 1) & 1);
    __syncthreads();
  } else if (!PF2) {
    uint4 pa0, pa1, pa2, pa3, pb0, pb1, pb2, pb3;
    GL16(p, 0);
    SW16(p, 0);
    __syncthreads();
#pragma unroll 1
    for (int kt = 0; kt < nk - 1; ++kt) {
      const int buf = kt & 1;
      GL16(p, kt + 1);
      __builtin_amdgcn_sched_barrier(0);
      compute(buf);
      SW16(p, buf ^ 1);
      __syncthreads();
    }
    compute((nk - 1) & 1);
    __syncthreads();
  } else {
    uint4 pa0, pa1, pa2, pa3, pb0, pb1, pb2, pb3;
    uint4 qa0, qa1, qa2, qa3, qb0, qb1, qb2, qb3;
    GL16(p, 0);
    if (nk > 1) GL16(q, 1);
    SW16(p, 0);
    __syncthreads();
    int kt = 0;
#pragma unroll 1
    for (; kt + 2 < nk; kt += 2) {
      GL16(p, kt + 2);
      __builtin_amdgcn_sched_barrier(0);
      compute(0);
      SW16(q, 1);
      __syncthreads();
      if (kt + 3 < nk) GL16(q, kt + 3);
      __builtin_amdgcn_sched_barrier(0);
      compute(1);
      SW16(p, 0);
      __syncthreads();
    }
    if (kt + 1 < nk) {
      compute(0);
      SW16(q, 1);
      __syncthreads();
      compute(1);
      __syncthreads();
    } else {
      compute(0);
      __syncthreads();
    }
  }
#undef GL32
#undef GL16
#undef SW32
#undef SW16
}

DI void zero_acc(f32x16 (&acc)[2][2]) {
#pragma unroll
  for (int a = 0; a < 2; ++a)
#pragma unroll
    for (int b = 0; b < 2; ++b)
#pragma unroll
      for (int i = 0; i < 16; ++i) acc[a][b][i] = 0.f;
}

DI void stage_acc(const f32x16 (&acc)[2][2], unsigned char* smem) {
  const int tid = otid(), lane = tid & 63, wave = tid >> 6;
  const int wm = wave >> 1, wn = wave & 1, hh = lane >> 5;
  float* Cs = (float*)smem;
#pragma unroll
  for (int mi = 0; mi < 2; ++mi)
#pragma unroll
    for (int ni = 0; ni < 2; ++ni)
#pragma unroll
      for (int i = 0; i < 16; ++i)
        Cs[(wm * 64 + mi * 32 + crow(i, hh)) * LDC + wn * 64 + ni * 32 + (lane & 31)] = acc[mi][ni][i];
  __syncthreads();
}

DI void gemm_tile256(f32x16 (&acc)[4][2], const bf16_t* __restrict__ A16, int lda,
                     const bf16_t* __restrict__ Bt, int ldb, int K, int m0, unsigned char* smem) {
  const int tid = otid(), lane = tid & 63, wave = tid >> 6;
  const int wm = wave >> 1, wn = wave & 1;
  bf16_t* As = (bf16_t*)smem;
  bf16_t* Bs = As + 256 * LDT;
  const int nk = K >> 6;
  const unsigned aoff32 = (unsigned)((tid >> 3) * lda + (tid & 7) * 8);
  const unsigned boff32 = (unsigned)((tid >> 3) * ldb + (tid & 7) * 8);
  const bf16_t* A16b = A16 + (size_t)m0 * lda;
  uint4 a0, a1, a2, a3, a4, a5, a6, a7, b0, b1, b2, b3;
#define GL256(kt_) { \
    const bf16_t* ab_ = A16b + (kt_) * 64; \
    a0 = *(const uint4*)((ab_ + 0 * 32 * lda) + aoff32); \
    a1 = *(const uint4*)((ab_ + 1 * 32 * lda) + aoff32); \
    a2 = *(const uint4*)((ab_ + 2 * 32 * lda) + aoff32); \
    a3 = *(const uint4*)((ab_ + 3 * 32 * lda) + aoff32); \
    a4 = *(const uint4*)((ab_ + 4 * 32 * lda) + aoff32); \
    a5 = *(const uint4*)((ab_ + 5 * 32 * lda) + aoff32); \
    a6 = *(const uint4*)((ab_ + 6 * 32 * lda) + aoff32); \
    a7 = *(const uint4*)((ab_ + 7 * 32 * lda) + aoff32); \
    const bf16_t* bb_ = Bt + (kt_) * 64; \
    b0 = *(const uint4*)((bb_ + 0 * 32 * ldb) + boff32); \
    b1 = *(const uint4*)((bb_ + 1 * 32 * ldb) + boff32); \
    b2 = *(const uint4*)((bb_ + 2 * 32 * ldb) + boff32); \
    b3 = *(const uint4*)((bb_ + 3 * 32 * ldb) + boff32); }
#define SW256() { \
    bf16_t* d_ = As + (tid >> 3) * LDT + (tid & 7) * 8; \
    *(uint4*)(d_ + 0 * 32 * LDT) = a0; *(uint4*)(d_ + 1 * 32 * LDT) = a1; \
    *(uint4*)(d_ + 2 * 32 * LDT) = a2; *(uint4*)(d_ + 3 * 32 * LDT) = a3; \
    *(uint4*)(d_ + 4 * 32 * LDT) = a4; *(uint4*)(d_ + 5 * 32 * LDT) = a5; \
    *(uint4*)(d_ + 6 * 32 * LDT) = a6; *(uint4*)(d_ + 7 * 32 * LDT) = a7; \
    bf16_t* d2_ = Bs + (tid >> 3) * LDT + (tid & 7) * 8; \
    *(uint4*)(d2_ + 0 * 32 * LDT) = b0; *(uint4*)(d2_ + 1 * 32 * LDT) = b1; \
    *(uint4*)(d2_ + 2 * 32 * LDT) = b2; *(uint4*)(d2_ + 3 * 32 * LDT) = b3; }
  auto compute = [&]() __attribute__((always_inline)) {
    const bf16_t* as = As + (wm * 128 + (lane & 31)) * LDT + (lane >> 5) * 8;
    const bf16_t* bs = Bs + (wn * 64 + (lane & 31)) * LDT + (lane >> 5) * 8;
#pragma unroll
    for (int ks = 0; ks < 4; ++ks) {
      bf16x8 fb0 = *(const bf16x8*)(bs + ks * 16);
      bf16x8 fb1 = *(const bf16x8*)(bs + 32 * LDT + ks * 16);
      bf16x8 fa0 = *(const bf16x8*)(as + ks * 16);
      bf16x8 fa1 = *(const bf16x8*)(as + 32 * LDT + ks * 16);
      bf16x8 fa2 = *(const bf16x8*)(as + 64 * LDT + ks * 16);
      bf16x8 fa3 = *(const bf16x8*)(as + 96 * LDT + ks * 16);
      acc[0][0] = MFMA32(fa0, fb0, acc[0][0]);
      acc[0][1] = MFMA32(fa0, fb1, acc[0][1]);
      acc[1][0] = MFMA32(fa1, fb0, acc[1][0]);
      acc[1][1] = MFMA32(fa1, fb1, acc[1][1]);
      acc[2][0] = MFMA32(fa2, fb0, acc[2][0]);
      acc[2][1] = MFMA32(fa2, fb1, acc[2][1]);
      acc[3][0] = MFMA32(fa3, fb0, acc[3][0]);
      acc[3][1] = MFMA32(fa3, fb1, acc[3][1]);
    }
  };
  __syncthreads();
  GL256(0);
  SW256();
  __syncthreads();
#pragma unroll 1
  for (int kt = 0; kt < nk - 1; ++kt) {
    GL256(kt + 1);
    __builtin_amdgcn_sched_barrier(0);
    compute();
    __syncthreads();
    SW256();
    __syncthreads();
  }
  compute();
  __syncthreads();
#undef GL256
#undef SW256
}

DI void zero_acc256(f32x16 (&acc)[4][2]) {
#pragma unroll
  for (int a = 0; a < 4; ++a)
#pragma unroll
    for (int b = 0; b < 2; ++b)
#pragma unroll
      for (int i = 0; i < 16; ++i) acc[a][b][i] = 0.f;
}

DI void stage_half(const f32x16 (&acc)[4][2], int hsel, unsigned char* smem) {
  const int tid = otid(), lane = tid & 63, wave = tid >> 6;
  const int wm = wave >> 1, wn = wave & 1, hh = lane >> 5;
  float* Cs = (float*)smem;
  if (wm == hsel) {
#pragma unroll
    for (int mi = 0; mi < 4; ++mi)
#pragma unroll
      for (int ni = 0; ni < 2; ++ni)
#pragma unroll
        for (int i = 0; i < 16; ++i)
          Cs[(mi * 32 + crow(i, hh)) * LDC + wn * 64 + ni * 32 + (lane & 31)] = acc[mi][ni][i];
  }
  __syncthreads();
}

DI void transpose_job(const float* __restrict__ src, bf16_t* __restrict__ dst, int K, int N,
                      const float* __restrict__ sc, int local, float* tile) {
  const int tid = otid();
  const int ntn = N >> 6;
  const int tk = local / ntn, tn = local - tk * ntn;
#pragma unroll
  for (int i = 0; i < 16; ++i) {
    int r = (tid >> 6) + 4 * i;
    float v = src[(size_t)(tk * 64 + r) * N + tn * 64 + (tid & 63)];
    if (sc) v *= sc[tk * 64 + r];
    tile[r * 65 + (tid & 63)] = v;
  }
  __syncthreads();
#pragma unroll
  for (int i = 0; i < 16; ++i) {
    int n = (tid >> 6) + 4 * i;
    dst[(size_t)(tn * 64 + n) * K + tk * 64 + (tid & 63)] = f2bf(tile[(tid & 63) * 65 + n]);
  }
  __syncthreads();
}

constexpr int NT_EARLY = 1376 + 16 + 16;
constexpr int NT_LATE = 1024 + 1024 + 256 + 256 + 64 + 128 + 128 + 16;
DI void transpose_early(const Params& P, int l, float* tile) {
  unsigned char* ws = P.ws;
  if (l < 1376) { transpose_job(P.in[3], (bf16_t*)(ws + OFF_WIN), 1024, 5504, P.in[2], l, tile); return; }
  l -= 1376;
  if (l < 16) { int d = l >> 3; transpose_job(P.in[7] + d * 64 * 512, (bf16_t*)(ws + OFF_W2T) + d * 512 * 64, 64, 512, nullptr, l & 7, tile); return; }
  l -= 16;
  { int d = l >> 3; transpose_job(P.in[9] + d * 64 * 512, (bf16_t*)(ws + OFF_A2T) + d * 512 * 64, 64, 512, nullptr, l & 7, tile); }
}
DI void transpose_late(const Params& P, int l, float* tile) {
  unsigned char* ws = P.ws;
  if (l < 1024) { transpose_job(P.in[25], (bf16_t*)(ws + OFF_W1), 1024, 4096, P.in[24], l, tile); return; }
  l -= 1024;
  if (l < 1024) { transpose_job(P.in[26], (bf16_t*)(ws + OFF_W2F), 4096, 1024, nullptr, l, tile); return; }
  l -= 1024;
  if (l < 256) { transpose_job(P.in[23], (bf16_t*)(ws + OFF_WOUT), 1024, 1024, nullptr, l, tile); return; }
  l -= 256;
  if (l < 256) { transpose_job(P.in[28], (bf16_t*)(ws + OFF_WPG), 1024, 1024, P.in[27], l, tile); return; }
  l -= 256;
  if (l < 64) { transpose_job(P.in[29], (bf16_t*)(ws + OFF_WPP), 256, 1024, nullptr, l, tile); return; }
  l -= 64;
  if (l < 128) { transpose_job(P.in[16], (bf16_t*)(ws + OFF_WOA), 512, 1024, nullptr, l, tile); return; }
  l -= 128;
  if (l < 128) { transpose_job(P.in[22], (bf16_t*)(ws + OFF_WOB), 512, 1024, nullptr, l, tile); return; }
  l -= 128;
  transpose_job(P.in[10], (bf16_t*)(ws + OFF_G2T), 128, 512, nullptr, l, tile);
}

DI void phase_prep(const Params& P, unsigned char* smem) {
  float* tile = (float*)smem;
  unsigned char* ws = P.ws;
  const int tid = otid(), lane = tid & 63, wave = tid >> 6;
  for (int w = blockIdx.x; w < NT_EARLY; w += gridDim.x) transpose_early(P, w, tile);
  float* small = (float*)(ws + OFF_SMALL);
  const float* x = P.in[0];
  for (int row = blockIdx.x * 4 + wave; row < T; row += gridDim.x * 4) {
    float s = 0.f;
#pragma unroll
    for (int i = 0; i < 4; ++i) {
      float4 v = *(const float4*)(x + (size_t)row * DM + (lane + 64 * i) * 4);
      s += v.x * v.x + v.y * v.y + v.z * v.z + v.w * v.w;
      *(uint2*)((bf16_t*)(ws + OFF_H0) + (size_t)row * DM + (lane + 64 * i) * 4) = pack4(v.x, v.y, v.z, v.w);
    }
    s = wave_sum(s);
    if (lane == 0) small[row] = rsqrtf(s * (1.0f / 1024.0f) + 1e-6f);
  }
  for (int i = blockIdx.x * NTHREADS + tid; i < 3 * T + 64; i += gridDim.x * NTHREADS) small[T + i] = 0.f;
}

__device__ __constant__ float c_invf[8] = {1.0f, 0.19392274474868576f, 0.03760603093086393f, 0.007292664737217109f,
                                           0.001414213562373095f, 0.0002742481756762073f, 5.318295896944988e-05f,
                                           1.031338537721246e-05f};

DI void rope_sincos(float ang, float& c, float& s) {
  float n = rintf(ang * 0.15915494309189535f);
  float r = fmaf(-n, 6.2831855f, ang);
  r = fmaf(-n, -1.7484555e-07f, r);
  s = __sinf(r);
  c = __cosf(r);
}

DI void phase_p1(const Params& P, unsigned char* smem) {
  unsigned char* ws = P.ws;
  const int tid = otid();
  const float* x = P.in[0];
  const bf16_t* WinT = (const bf16_t*)(ws + OFF_WIN);
  const float* rstd0 = (const float*)(ws + OFF_SMALL);
  bf16_t* UR = (bf16_t*)P.out;
  bf16_t* Qb = (bf16_t*)(ws + OFF_Q);
  bf16_t* Kb = (bf16_t*)(ws + OFF_K);
  bf16_t* Vt = (bf16_t*)(ws + OFF_VT);
  const float* Cs = (const float*)smem;
  constexpr float QSCALE = 0.18033688011112042f;
  auto epi = [&](int m0, int nt) __attribute__((always_inline)) {
    const int b = m0 >> 13;
    if (nt >= 15 && nt < 23) {
      float* Cw = (float*)smem;
#pragma unroll 2
      for (int it = 0; it < 8; ++it) {
        const int idx = tid + 256 * it;
        const int fi = idx & 7, hl = (idx >> 3) & 1, row = idx >> 4;
        const int pos = (m0 + row) & (SEQ - 1);
        float c, s;
        rope_sincos((float)pos * c_invf[fi], c, s);
        float* p1 = Cw + row * LDC + hl * 64 + fi;
        const float x1 = p1[0], x2 = p1[8];
        p1[0] = x1 * c - x2 * s;
        p1[8] = x2 * c + x1 * s;
      }
      __syncthreads();
    }
    if (nt < 23) {
#pragma unroll 4
      for (int it = 0; it < 16; ++it) {
        int idx = tid + 256 * it, row = idx >> 5, c4 = (idx & 31) * 4;
        int grow = m0 + row;
        float rs = rstd0[grow];
        float4 v = *(const float4*)(Cs + row * LDC + c4);
        v.x *= rs; v.y *= rs; v.z *= rs; v.w *= rs;
        if (nt < 15) {
          *(uint2*)(UR + (size_t)grow * 1920 + nt * 128 + c4) = pack4(v.x, v.y, v.z, v.w);
        } else {
          const bool isq = nt < 19;
          const int hc = (nt - (isq ? 15 : 19)) * 2 + (c4 >> 6);
          const int d = c4 & 63;
          const int pos = grow & (SEQ - 1);
          if (isq) { v.x *= QSCALE; v.y *= QSCALE; v.z *= QSCALE; v.w *= QSCALE; }
          bf16_t* dst = (isq ? Qb : Kb) + ((size_t)(b * 8 + hc) * SEQ + pos) * 64 + d;
          *(uint2*)dst = pack4(v.x, v.y, v.z, v.w);
        }
      }
    } else {
      const int h = nt - 23;
      const int s0 = m0 & (SEQ - 1);
#pragma unroll 2
      for (int it = 0; it < 8; ++it) {
        int idx = tid + 256 * it, dv = idx & 127, rg = idx >> 7;
        float vals[8];
#pragma unroll
        for (int j = 0; j < 8; ++j) vals[j] = Cs[(rg * 8 + j) * LDC + dv] * rstd0[m0 + rg * 8 + j];
        uint4 o;
        o.x = pack2(vals[0], vals[1]); o.y = pack2(vals[2], vals[3]);
        o.z = pack2(vals[4], vals[5]); o.w = pack2(vals[6], vals[7]);
        *(uint4*)(Vt + ((size_t)(b * 4 + h) * 128 + dv) * SEQ + s0 + rg * 8) = o;
      }
    }
  };
#pragma unroll 1
  for (int ta = blockIdx.x; ta < 1536; ta += gridDim.x) {
    const int x = ta & 7, j = ta >> 3, q = j & 63;
    const int nt = (j >> 6) * 8 + (q >> 3), mt = x * 8 + (q & 7);
    const int m0 = mt * 256;
    f32x16 acc[4][2];
    zero_acc256(acc);
    gemm_tile256(acc, (const bf16_t*)(ws + OFF_H0), DM, WinT + (size_t)nt * 128 * DM, DM, DM, m0, smem);
#pragma unroll 1
    for (int hsel = 0; hsel < 2; ++hsel) {
      stage_half(acc, hsel, smem);
      epi(m0 + hsel * 128, nt);
      __syncthreads();
    }
  }
#pragma unroll 1
  for (int tb = blockIdx.x; tb < 384; tb += gridDim.x) {
    const int x = tb & 7, j = tb >> 3;
    const int nt = 24 + (j >> 4), mt = x * 16 + (j & 15);
    const int m0 = mt * 128;
    f32x16 acc[2][2];
    zero_acc(acc);
    gemm_tile<false>(acc, (const bf16_t*)(ws + OFF_H0), DM, WinT + (size_t)nt * 128 * DM, DM, DM, m0, smem);
    stage_acc(acc, smem);
    epi(m0, nt);
  }
}

DI void phase_e1(const Params& P) {
  unsigned char* ws = P.ws;
  const int tid = otid(), lane = tid & 63, wave = tid >> 6;
  const bf16_t* UR = (const bf16_t*)P.out;
  const float* mup = P.in[4];
  const float* mun = P.in[5];
  const float* k_k = P.in[11];
  bf16_t* R = (bf16_t*)(ws + OFF_S);
  bf16_t* V = R + (size_t)T * 512;
  bf16_t* NKK = V + (size_t)T * 512;
  bf16_t* KT = (bf16_t*)(ws + OFF_KTMP);
  bf16_t* AWD = (bf16_t*)(ws + OFF_AWD);
  bf16_t* AAD = (bf16_t*)(ws + OFF_AAD);
  bf16_t* AGD = (bf16_t*)(ws + OFF_AGD);
  const float4 zero4 = make_float4(0.f, 0.f, 0.f, 0.f);
  for (int g = blockIdx.x * 4 + wave; g < T / 8; g += gridDim.x * 4) {
    const int t0 = g * 8;
#pragma unroll
    for (int i = 0; i < 8; ++i) {
      const int c = 4 * lane + 256 * i;
      if (c < 1920) {
        const float4 mp = *(const float4*)(mup + c);
        const float4 mn = *(const float4*)(mun + c);
        float4 kk4 = zero4;
        if (i == 2 || i == 3) kk4 = *(const float4*)(k_k + (c - 512));
        const bf16_t* up_ = UR + (size_t)t0 * 1920 + c;
        float4 prv = ((t0 & (SEQ - 1)) > 0) ? unpack4(*(const uint2*)(up_ - 1920)) : zero4;
        float4 u = unpack4(*(const uint2*)(up_));
#pragma unroll
        for (int tt = 0; tt < 8; ++tt) {
          const int t = t0 + tt;
          const float4 un = ((t & (SEQ - 1)) < SEQ - 1) ? unpack4(*(const uint2*)(up_ + (size_t)(tt + 1) * 1920)) : zero4;
          float4 s;
          s.x = u.x + mp.x * (prv.x - u.x) + mn.x * (un.x - u.x);
          s.y = u.y + mp.y * (prv.y - u.y) + mn.y * (un.y - u.y);
          s.z = u.z + mp.z * (prv.z - u.z) + mn.z * (un.z - u.z);
          s.w = u.w + mp.w * (prv.w - u.w) + mn.w * (un.w - u.w);
          if (i < 2) {
            *(uint2*)(R + (size_t)t * 512 + c) = pack4(s.x, s.y, s.z, s.w);
          } else if (i < 4) {
            const int cc = c - 512;
            float4 q = make_float4(s.x * kk4.x, s.y * kk4.y, s.z * kk4.z, s.w * kk4.w);
            float ss = q.x * q.x + q.y * q.y + q.z * q.z + q.w * q.w;
            ss = row16_sum(ss);
            float inv = -1.0f / fmaxf(sqrtf(ss), 1e-12f);
            *(uint2*)(KT + (size_t)t * 512 + cc) = pack4(s.x, s.y, s.z, s.w);
            *(uint2*)(NKK + (size_t)t * 512 + cc) = pack4(q.x * inv, q.y * inv, q.z * inv, q.w * inv);
          } else if (i < 6) {
            *(uint2*)(V + (size_t)t * 512 + (c - 1024)) = pack4(s.x, s.y, s.z, s.w);
          } else if (c < 1664) {
            float4 o;
            o.x = 1.f - 2.f / (1.f + __expf(2.f * s.x)); o.y = 1.f - 2.f / (1.f + __expf(2.f * s.y));
            o.z = 1.f - 2.f / (1.f + __expf(2.f * s.z)); o.w = 1.f - 2.f / (1.f + __expf(2.f * s.w));
            *(uint2*)(AWD + (size_t)t * 128 + (c - 1536)) = pack4(o.x, o.y, o.z, o.w);
          } else if (c < 1792) {
            *(uint2*)(AAD + (size_t)t * 128 + (c - 1664)) = pack4(s.x, s.y, s.z, s.w);
          } else {
            *(uint2*)(AGD + (size_t)t * 128 + (c - 1792)) =
                pack4(sigmoidf_(s.x), sigmoidf_(s.y), sigmoidf_(s.z), sigmoidf_(s.w));
          }
          prv = u;
          u = un;
        }
      }
    }
  }
}

DI void phase_lora(const Params& P, unsigned char* smem) {
  unsigned char* ws = P.ws;
  const int tid = otid();
  const float* Cs = (const float*)smem;
  bf16_t* Sb = (bf16_t*)(ws + OFF_S);
  const bf16_t* NKK = Sb + 2 * (size_t)T * 512;
  const bf16_t* KT = (const bf16_t*)(ws + OFF_KTMP);
  const float* w0 = P.in[6];
  const float* a0 = P.in[8];
  const float* k_a = P.in[12];
  for (int item = blockIdx.x; item < 128 * 16; item += gridDim.x) {
    const int kind = item & 3, nt = (item >> 2) & 3, mt = item >> 4;
    const int d = kind & 1;
    const bool isdecay = kind < 2;
    const int m0 = mt * 128;
    const bf16_t* A = (const bf16_t*)(ws + (isdecay ? OFF_AWD : OFF_AAD)) + d * 64;
    const bf16_t* Bt = (const bf16_t*)(ws + (isdecay ? OFF_W2T : OFF_A2T)) + (size_t)d * 512 * 64 + (size_t)nt * 128 * 64;
    f32x16 acc[2][2];
    zero_acc(acc);
    gemm_tile<false>(acc, A, 128, Bt, 64, 64, m0, smem);
    stage_acc(acc, smem);
    bf16_t* E = Sb + (size_t)(3 + d) * T * 512;
    bf16_t* KD = Sb + (size_t)(5 + d) * T * 512;
    bf16_t* BB = Sb + (size_t)(7 + d) * T * 512;
#pragma unroll 4
    for (int it = 0; it < 16; ++it) {
      int idx = tid + 256 * it, row = idx >> 5, c4 = (idx & 31) * 4;
      size_t grow = m0 + row;
      int c = nt * 128 + c4;
      float4 v = *(const float4*)(Cs + row * LDC + c4);
      if (isdecay) {
        float4 b4 = *(const float4*)(w0 + d * 512 + c);
        const float E5 = 0.6065306597126334f;
        *(uint2*)(E + grow * 512 + c) = pack4(E5 * sigmoidf_(v.x + b4.x), E5 * sigmoidf_(v.y + b4.y),
                                              E5 * sigmoidf_(v.z + b4.z), E5 * sigmoidf_(v.w + b4.w));
      } else {
        float4 b4 = *(const float4*)(a0 + d * 512 + c);
        float4 ka = *(const float4*)(k_a + c);
        float4 k = unpack4(*(const uint2*)(KT + grow * 512 + c));
        float4 nk = unpack4(*(const uint2*)(NKK + grow * 512 + c));
        float ax = sigmoidf_(v.x + b4.x), ay = sigmoidf_(v.y + b4.y), az = sigmoidf_(v.z + b4.z), aw = sigmoidf_(v.w + b4.w);
        *(uint2*)(KD + grow * 512 + c) = pack4(k.x * (1.f + (ax - 1.f) * ka.x), k.y * (1.f + (ay - 1.f) * ka.y),
                                               k.z * (1.f + (az - 1.f) * ka.z), k.w * (1.f + (aw - 1.f) * ka.w));
        *(uint2*)(BB + grow * 512 + c) = pack4(-nk.x * ax, -nk.y * ay, -nk.z * az, -nk.w * aw);
      }
    }
  }
}

typedef float f2 __attribute__((ext_vector_type(2)));
struct ScanOps { float4 r4, nk, w4, kd, bb; float v; };

template <int DIR>
DI void scan_item(const Params& P, int item, unsigned char* smem) {
  unsigned char* ws = P.ws;
  const int tid = otid(), lane = tid & 63;
  const int wave = __builtin_amdgcn_readfirstlane(tid >> 6);
  const int rg8 = item & 7, h = (item >> 4) & 7, b = item >> 7;
  constexpr int BUFSTRIDE = 5 * 16 * 64 + 16 * 8;
  constexpr int NCH = SEQ / 16;
  float* Xs0 = (float*)smem;
  const bf16_t* Sb = (const bf16_t*)(ws + OFF_S);
  const size_t tokbase = (size_t)b * SEQ;
  if (wave >= 2) {
    const bf16_t* arr0 = Sb;
    const bf16_t* arr1 = Sb + 2 * (size_t)T * 512;
    const bf16_t* arr2 = Sb + (size_t)(3 + DIR) * T * 512;
    const bf16_t* arr3 = Sb + (size_t)(5 + DIR) * T * 512;
    const bf16_t* arr4 = Sb + (size_t)(7 + DIR) * T * 512;
    const bf16_t* Vg = Sb + (size_t)T * 512;
    const int lt = tid - 128;
    const int stp = lt >> 3, part = lt & 7;
    const unsigned loff = (unsigned)(stp * 512 + h * 64 + part * 8);
    const unsigned voff = (unsigned)((lt & 15) * 512 + h * 64 + rg8 * 8);
    uint4 a0, a1, a2, a3, a4, av, b0, b1, b2, b3, b4, bv;
    av = make_uint4(0, 0, 0, 0); bv = av;
#define SCAN_GL(c, r0, r1, r2, r3, r4, rv) { \
      const int tlo_ = DIR ? (SEQ - 16 - 16 * (c)) : 16 * (c); \
      const size_t ub_ = (tokbase + tlo_) * 512; \
      r0 = *(const uint4*)(arr0 + ub_ + loff); r1 = *(const uint4*)(arr1 + ub_ + loff); \
      r2 = *(const uint4*)(arr2 + ub_ + loff); r3 = *(const uint4*)(arr3 + ub_ + loff); \
      r4 = *(const uint4*)(arr4 + ub_ + loff); \
      if (lt < 16) rv = *(const uint4*)(Vg + ub_ + voff); }
    auto st8 = [&](float* dst, uint4 v, bool isw) __attribute__((always_inline)) {
      float f0 = bf2f(v.x & 0xffffu), f1 = bf2f(v.x >> 16), f2_ = bf2f(v.y & 0xffffu), f3 = bf2f(v.y >> 16);
      float f4 = bf2f(v.z & 0xffffu), f5 = bf2f(v.z >> 16), f6 = bf2f(v.w & 0xffffu), f7 = bf2f(v.w >> 16);
      if (isw) {
        f0 = __expf(-f0); f1 = __expf(-f1); f2_ = __expf(-f2_); f3 = __expf(-f3);
        f4 = __expf(-f4); f5 = __expf(-f5); f6 = __expf(-f6); f7 = __expf(-f7);
      }
      *(float4*)(dst) = make_float4(f0, f1, f2_, f3);
      *(float4*)(dst + 4) = make_float4(f4, f5, f6, f7);
    };
#define SCAN_SW(c, r0, r1, r2, r3, r4, rv) { \
      float* X_ = Xs0 + ((c) & 1) * BUFSTRIDE; \
      st8(X_ + (0 * 16 + stp) * 64 + part * 8, r0, false); st8(X_ + (1 * 16 + stp) * 64 + part * 8, r1, false); \
      st8(X_ + (2 * 16 + stp) * 64 + part * 8, r2, true);  st8(X_ + (3 * 16 + stp) * 64 + part * 8, r3, false); \
      st8(X_ + (4 * 16 + stp) * 64 + part * 8, r4, false); \
      if (lt < 16) st8(X_ + 5120 + lt * 8, rv, false); }
    SCAN_GL(0, a0, a1, a2, a3, a4, av);
    SCAN_GL(1, b0, b1, b2, b3, b4, bv);
    SCAN_SW(0, a0, a1, a2, a3, a4, av);
    SCAN_GL(2, a0, a1, a2, a3, a4, av);
    __syncthreads();
#pragma unroll 1
    for (int c = 0; c < NCH; c += 2) {
      if (c + 1 < NCH) SCAN_SW(c + 1, b0, b1, b2, b3, b4, bv);
      if (c + 3 < NCH) SCAN_GL(c + 3, b0, b1, b2, b3, b4, bv);
      __syncthreads();
      if (c + 2 < NCH) SCAN_SW(c + 2, a0, a1, a2, a3, a4, av);
      if (c + 4 < NCH) SCAN_GL(c + 4, a0, a1, a2, a3, a4, av);
      __syncthreads();
    }
#undef SCAN_GL
#undef SCAN_SW
  } else {
    const int cg = lane & 15, rowq = lane >> 4;
    const int rowl = wave * 4 + rowq;
    const int row = rg8 * 8 + rowl;
    bf16_t* Y = (bf16_t*)P.out + (size_t)DIR * T * 512;
    f2 S01 = {0.f, 0.f}, S23 = {0.f, 0.f};
    float ysel = 0.f;
    float4 rprev = make_float4(0.f, 0.f, 0.f, 0.f);
    __syncthreads();
#pragma unroll 1
    for (int c = 0; c < NCH; ++c) {
      const float* xbase = Xs0 + (c & 1) * BUFSTRIDE + cg * 4;
      const float* vbase = Xs0 + (c & 1) * BUFSTRIDE + 5120 + rowl;
      auto ld = [&](ScanOps& o, int j) __attribute__((always_inline)) {
        const int jj = DIR ? 15 - j : j;
        const float* xs = xbase + jj * 64;
        o.r4 = *(const float4*)(xs);
        o.nk = *(const float4*)(xs + 1024);
        o.w4 = *(const float4*)(xs + 2048);
        o.kd = *(const float4*)(xs + 3072);
        o.bb = *(const float4*)(xs + 4096);
        o.v = vbase[jj * 8];
      };
      ScanOps q0, q1, q2;
      ld(q0, 0);
      ld(q1, 1);
#pragma unroll
      for (int j = 0; j < 16; ++j) {
        if (j + 2 < 16) ld(q2, j + 2);
        const ScanOps& cur = q0;
        f2 t = S01 * (f2){cur.nk.x, cur.nk.y};
        t = S23 * (f2){cur.nk.z, cur.nk.w} + t;
        f2 qy = S01 * (f2){rprev.x, rprev.y};
        qy = S23 * (f2){rprev.z, rprev.w} + qy;
        float p = t.x + t.y;
        float y = qy.x + qy.y;
        f2 vv = {cur.v, cur.v};
        f2 u01 = vv * (f2){cur.kd.x, cur.kd.y};
        f2 u23 = vv * (f2){cur.kd.z, cur.kd.w};
        p = dpp_add<0x128>(p); y = dpp_add<0x128>(y);
        p = dpp_add<0x124>(p); y = dpp_add<0x124>(y);
        p = dpp_add<0x122>(p); y = dpp_add<0x122>(y);
        p = dpp_add<0x121>(p); y = dpp_add<0x121>(y);
        f2 pp = {p, p};
        u01 = pp * (f2){cur.bb.x, cur.bb.y} + u01;
        u23 = pp * (f2){cur.bb.z, cur.bb.w} + u23;
        S01 = S01 * (f2){cur.w4.x, cur.w4.y} + u01;
        S23 = S23 * (f2){cur.w4.z, cur.w4.w} + u23;
        if (j == 0) {
          ysel = (cg == 15) ? y : ysel;
          if (c > 0) {
            const int n = (c - 1) * 16 + cg;
            const int t_ = DIR ? (SEQ - 1 - n) : n;
            Y[(tokbase + t_) * 512 + h * 64 + row] = (bf16_t)(pack2(ysel, 0.f) & 0xffffu);
          }
        } else {
          ysel = (cg == j - 1) ? y : ysel;
        }
        rprev = cur.r4;
        q0 = q1;
        q1 = q2;
      }
      __syncthreads();
    }
    {
      f2 qy = S01 * (f2){rprev.x, rprev.y};
      qy = S23 * (f2){rprev.z, rprev.w} + qy;
      float y = qy.x + qy.y;
      y = row16_sum(y);
      ysel = (cg == 15) ? y : ysel;
      const int n = (NCH - 1) * 16 + cg;
      const int t_ = DIR ? (SEQ - 1 - n) : n;
      Y[(tokbase + t_) * 512 + h * 64 + row] = (bf16_t)(pack2(ysel, 0.f) & 0xffffu);
    }
  }
}

constexpr int KLD = 72;
constexpr int VLD = 68;

DI void attn_item(const Params& P, int item, unsigned char* smem, float lam) {
  unsigned char* ws = P.ws;
  const int tid = otid(), lane = tid & 63, wave = tid >> 6;
  const int hh = lane >> 5;
  const int qb = item & 63, h = (item >> 6) & 3, b = item >> 8;
  const int q0 = qb * 128 + wave * 32;
  bf16_t* Ks = (bf16_t*)smem;
  bf16_t* Vs = Ks + 2 * 64 * KLD;
  const bf16_t* Qg = (const bf16_t*)(ws + OFF_Q);
  const bf16_t* Kg = (const bf16_t*)(ws + OFF_K);
  const bf16_t* Vp = (const bf16_t*)(ws + OFF_VT) + (size_t)(b * 4 + h) * 128 * SEQ;
  const float* subln = P.in[21];
  bf16_t* YB = (bf16_t*)(ws + OFF_YB);
#pragma unroll 1
  for (int ci = 0; ci < 2; ++ci) {
    const int hc = h * 2 + (1 - ci);
    const bf16_t* Qp = Qg + ((size_t)(b * 8 + hc) * SEQ + q0 + (lane & 31)) * 64 + hh * 8;
    bf16x8 qf[4];
#pragma unroll
    for (int ks = 0; ks < 4; ++ks) qf[ks] = *(const bf16x8*)(Qp + ks * 16);
    const bf16_t* Kp = Kg + (size_t)(b * 8 + hc) * SEQ * 64;
    f32x16 o[4];
#pragma unroll
    for (int mt = 0; mt < 4; ++mt)
#pragma unroll
      for (int i = 0; i < 16; ++i) o[mt][i] = 0.f;
    float m_run = 0.f, l_run = 0.f;
    uint4 kr0, kr1, vr0, vr1, vr2, vr3;
    const unsigned koff32 = (unsigned)((tid >> 3) * 64 + (tid & 7) * 8);
    const unsigned voff32 = (unsigned)((tid >> 3) * SEQ + (tid & 7) * 8);
    auto glk = [&](int kt) __attribute__((always_inline)) {
      const bf16_t* kb_ = Kp + kt * 4096;
      kr0 = *(const uint4*)(kb_ + koff32);
      kr1 = *(const uint4*)((kb_ + 2048) + koff32);
    };
    auto glv = [&](int kt) __attribute__((always_inline)) {
      const bf16_t* vb_ = Vp + kt * 64;
      vr0 = *(const uint4*)(vb_ + voff32);
      vr1 = *(const uint4*)((vb_ + 32 * SEQ) + voff32);
      vr2 = *(const uint4*)((vb_ + 64 * SEQ) + voff32);
      vr3 = *(const uint4*)((vb_ + 96 * SEQ) + voff32);
    };
    const int sw_r = tid >> 3, sw_p = (tid & 7) * 8;
    auto swv = [&](bf16_t* dst, uint4 v) __attribute__((always_inline)) {
      *(uint2*)(dst) = make_uint2(v.x, v.y);
      *(uint2*)(dst + 4) = make_uint2(v.z, v.w);
    };
    auto sw = [&](int buf) __attribute__((always_inline)) {
      bf16_t* kd = Ks + buf * 64 * KLD + sw_r * KLD + sw_p;
      *(uint4*)(kd) = kr0;
      *(uint4*)(kd + 32 * KLD) = kr1;
      bf16_t* vd = Vs + buf * 128 * VLD + sw_r * VLD + sw_p;
      swv(vd, vr0);
      swv(vd + 32 * VLD, vr1);
      swv(vd + 64 * VLD, vr2);
      swv(vd + 96 * VLD, vr3);
    };
    __syncthreads();
    glk(0);
    glv(0);
    sw(0);
    __syncthreads();
#pragma unroll 1
    for (int kt = 0; kt < 128; ++kt) {
      const int buf = kt & 1;
      const bf16_t* kb = Ks + buf * 64 * KLD + (lane & 31) * KLD + hh * 8;
      const bf16x8 ka0 = *(const bf16x8*)(kb + 0), ka1 = *(const bf16x8*)(kb + 16);
      const bf16x8 ka2 = *(const bf16x8*)(kb + 32), ka3 = *(const bf16x8*)(kb + 48);
      if (kt + 1 < 128) glk(kt + 1);
      __builtin_amdgcn_sched_barrier(0);
      f32x16 st0, st1;
      const bf16x8 kc0 = *(const bf16x8*)(kb + 32 * KLD + 0), kc1 = *(const bf16x8*)(kb + 32 * KLD + 16);
      const bf16x8 kc2 = *(const bf16x8*)(kb + 32 * KLD + 32), kc3 = *(const bf16x8*)(kb + 32 * KLD + 48);
      __builtin_amdgcn_sched_barrier(0);
      if (__any(m_run != 0.f)) {
        const float ninit = -m_run;
#pragma unroll
        for (int i = 0; i < 16; ++i) { st0[i] = ninit; st1[i] = ninit; }
        st0 = MFMA32(ka0, qf[0], st0);
        st0 = MFMA32(ka1, qf[1], st0);
        st0 = MFMA32(ka2, qf[2], st0);
        st0 = MFMA32(ka3, qf[3], st0);
        st1 = MFMA32(kc0, qf[0], st1);
        st1 = MFMA32(kc1, qf[1], st1);
        st1 = MFMA32(kc2, qf[2], st1);
        st1 = MFMA32(kc3, qf[3], st1);
      } else {
        f32x16 z;
#pragma unroll
        for (int i = 0; i < 16; ++i) z[i] = 0.f;
        st0 = MFMA32(ka0, qf[0], z);
        st0 = MFMA32(ka1, qf[1], st0);
        st0 = MFMA32(ka2, qf[2], st0);
        st0 = MFMA32(ka3, qf[3], st0);
        st1 = MFMA32(kc0, qf[0], z);
        st1 = MFMA32(kc1, qf[1], st1);
        st1 = MFMA32(kc2, qf[2], st1);
        st1 = MFMA32(kc3, qf[3], st1);
      }
      const bf16_t* vb = Vs + buf * 128 * VLD + (lane & 31) * VLD + hh * 4;
      s16x4 vl0 = *(const s16x4*)(vb + 0 * 32 * VLD), vh0 = *(const s16x4*)(vb + 0 * 32 * VLD + 8);
      s16x4 vl1 = *(const s16x4*)(vb + 1 * 32 * VLD), vh1 = *(const s16x4*)(vb + 1 * 32 * VLD + 8);
      s16x4 vl2 = *(const s16x4*)(vb + 2 * 32 * VLD), vh2 = *(const s16x4*)(vb + 2 * 32 * VLD + 8);
      s16x4 vl3 = *(const s16x4*)(vb + 3 * 32 * VLD), vh3 = *(const s16x4*)(vb + 3 * 32 * VLD + 8);
      if (kt + 1 < 128) glv(kt + 1);
      __builtin_amdgcn_sched_barrier(0);
      float mx = st0[0];
#pragma unroll
      for (int i = 0; i < 16; ++i) { mx = fmaxf(mx, st0[i]); mx = fmaxf(mx, st1[i]); }
      mx = xor32_max(mx);
      const bool first = (kt == 0);
      if (__any(mx > 40.0f) || (first && __any(mx < -40.0f))) {
        const float delta = first ? mx : fmaxf(mx, 0.f);
        const float alpha = first ? 1.0f : __builtin_amdgcn_exp2f(-delta);
        m_run += delta;
        l_run *= alpha;
#pragma unroll
        for (int i = 0; i < 16; ++i) { st0[i] -= delta; st1[i] -= delta; }
#pragma unroll
        for (int mt = 0; mt < 4; ++mt)
#pragma unroll
          for (int i = 0; i < 16; ++i) o[mt][i] *= alpha;
      }
      float ps = 0.f;
#pragma unroll
      for (int i = 0; i < 16; ++i) {
        st0[i] = __builtin_amdgcn_exp2f(st0[i]);
        st1[i] = __builtin_amdgcn_exp2f(st1[i]);
        ps += st0[i] + st1[i];
      }
      l_run += ps;
#pragma unroll
      for (int k4 = 0; k4 < 4; ++k4) {
        const int sub = k4 & 1;
        u32x4 pu;
        if (k4 < 2) {
          pu[0] = pack2(st0[8 * sub + 0], st0[8 * sub + 1]);
          pu[1] = pack2(st0[8 * sub + 2], st0[8 * sub + 3]);
          pu[2] = pack2(st0[8 * sub + 4], st0[8 * sub + 5]);
          pu[3] = pack2(st0[8 * sub + 6], st0[8 * sub + 7]);
        } else {
          pu[0] = pack2(st1[8 * sub + 0], st1[8 * sub + 1]);
          pu[1] = pack2(st1[8 * sub + 2], st1[8 * sub + 3]);
          pu[2] = pack2(st1[8 * sub + 4], st1[8 * sub + 5]);
          pu[3] = pack2(st1[8 * sub + 6], st1[8 * sub + 7]);
        }
        const bf16x8 pfv = __builtin_bit_cast(bf16x8, pu);
        const bf16x8 vf0 = __builtin_shufflevector(vl0, vh0, 0, 1, 2, 3, 4, 5, 6, 7);
        const bf16x8 vf1 = __builtin_shufflevector(vl1, vh1, 0, 1, 2, 3, 4, 5, 6, 7);
        const bf16x8 vf2 = __builtin_shufflevector(vl2, vh2, 0, 1, 2, 3, 4, 5, 6, 7);
        const bf16x8 vf3 = __builtin_shufflevector(vl3, vh3, 0, 1, 2, 3, 4, 5, 6, 7);
        if (k4 < 3) {
          const bf16_t* vn = vb + (k4 + 1) * 16;
          vl0 = *(const s16x4*)(vn + 0 * 32 * VLD); vh0 = *(const s16x4*)(vn + 0 * 32 * VLD + 8);
          vl1 = *(const s16x4*)(vn + 1 * 32 * VLD); vh1 = *(const s16x4*)(vn + 1 * 32 * VLD + 8);
          vl2 = *(const s16x4*)(vn + 2 * 32 * VLD); vh2 = *(const s16x4*)(vn + 2 * 32 * VLD + 8);
          vl3 = *(const s16x4*)(vn + 3 * 32 * VLD); vh3 = *(const s16x4*)(vn + 3 * 32 * VLD + 8);
        }
        __builtin_amdgcn_sched_barrier(0);
        o[0] = MFMA32(vf0, pfv, o[0]);
        o[1] = MFMA32(vf1, pfv, o[1]);
        o[2] = MFMA32(vf2, pfv, o[2]);
        o[3] = MFMA32(vf3, pfv, o[3]);
      }
      if (kt + 1 < 128) sw(buf ^ 1);
      __syncthreads();
    }
    float l = xor32_sum(l_run);
    float inv = 1.0f / l;
    const size_t tok = (size_t)b * SEQ + q0 + (lane & 31);
    if (ci == 0) {
      const float sc = inv * lam;
#pragma unroll
      for (int mt = 0; mt < 4; ++mt)
#pragma unroll
        for (int g = 0; g < 4; ++g) {
          const int dv = 32 * mt + 8 * g + 4 * hh;
          *(uint2*)(YB + tok * 512 + h * 128 + dv) =
              pack4(o[mt][4 * g + 0] * sc, o[mt][4 * g + 1] * sc, o[mt][4 * g + 2] * sc, o[mt][4 * g + 3] * sc);
        }
    } else {
      float ss = 0.f;
#pragma unroll
      for (int mt = 0; mt < 4; ++mt)
#pragma unroll
        for (int g = 0; g < 4; ++g) {
          const int dv = 32 * mt + 8 * g + 4 * hh;
          float4 sv = unpack4(*(const uint2*)(YB + tok * 512 + h * 128 + dv));
          float d0 = o[mt][4 * g + 0] * inv - sv.x, d1 = o[mt][4 * g + 1] * inv - sv.y;
          float d2 = o[mt][4 * g + 2] * inv - sv.z, d3 = o[mt][4 * g + 3] * inv - sv.w;
          o[mt][4 * g + 0] = d0; o[mt][4 * g + 1] = d1; o[mt][4 * g + 2] = d2; o[mt][4 * g + 3] = d3;
          ss += d0 * d0 + d1 * d1 + d2 * d2 + d3 * d3;
        }
      ss = xor32_sum(ss);
      const float rinv = rsqrtf(ss * (1.0f / 128.0f) + 1e-5f) * 0.8f;
#pragma unroll
      for (int mt = 0; mt < 4; ++mt)
#pragma unroll
        for (int g = 0; g < 4; ++g) {
          const int dv = 32 * mt + 8 * g + 4 * hh;
          float4 sw4 = *(const float4*)(subln + dv);
          *(uint2*)(YB + tok * 512 + h * 128 + dv) =
              pack4(o[mt][4 * g + 0] * rinv * sw4.x, o[mt][4 * g + 1] * rinv * sw4.y,
                    o[mt][4 * g + 2] * rinv * sw4.z, o[mt][4 * g + 3] * rinv * sw4.w);
        }
    }
  }
}

DI void phase_mix(const Params& P, unsigned char* smem, int* s_item, int rep = 0, int mode = 3) {
  const int tid = otid();
  if (mode & 1) {
    const bool remap = (gridDim.x == 512);
    for (int sb = blockIdx.x; sb < 256; sb += gridDim.x) {
      const int j = sb >> 3;
      const int si = remap ? ((((sb & 7) * 4 + (j >> 3)) << 3) | (j & 7)) : sb;
      if ((si >> 3) & 1) scan_item<1>(P, si, smem); else scan_item<0>(P, si, smem);
    }
  }
  if (!(mode & 2)) return;
  float a = 0.f, bsum = 0.f;
  {
    const int lane = tid & 63;
    a = P.in[17][lane] * P.in[18][lane];
    bsum = P.in[19][lane] * P.in[20][lane];
    a = wave_sum(a); bsum = wave_sum(bsum);
  }
  const float lam = __expf(a) - __expf(bsum) + 0.2f;
  int* counters = (int*)(P.ws + OFF_SMALL) + 4 * T + rep * 8;
  const int x0 = (int)(xb_xcc_id() & 7u);
  if (tid == 0) s_item[1] = 0;
  for (;;) {
    __syncthreads();
    if (tid == 0) {
      int item = -1;
      int k = s_item[1];
      while (k < 8) {
        const int q = (x0 + k) & 7;
        const int idx = atomicAdd(counters + q, 1);
        if (idx < 64) { item = q * 64 + idx; break; }
        ++k;
      }
      s_item[1] = k;
      s_item[0] = item;
    }
    __syncthreads();
    const int item = __builtin_amdgcn_readfirstlane(*s_item);
    if (item < 0) break;
    attn_item(P, item, smem, lam);
  }
  if (rep == 0) {
    int* tcount = (int*)(P.ws + OFF_SMALL) + 4 * T + 32;
    const float* x = P.in[0];
    bf16_t* H0b = (bf16_t*)P.out + (size_t)T * DM;
    for (;;) {
      __syncthreads();
      if (tid == 0) s_item[0] = atomicAdd(tcount, 1);
      __syncthreads();
      const int l = __builtin_amdgcn_readfirstlane(s_item[0]);
      if (l >= NT_LATE + 256) break;
      if (l < NT_LATE) {
        transpose_late(P, l, (float*)smem);
      } else {
        const size_t base = (size_t)(l - NT_LATE) * 64 * DM;
#pragma unroll 4
        for (int i = 0; i < 64; ++i) {
          const size_t o = base + (size_t)i * DM + tid * 4;
          float4 v = *(const float4*)(x + o);
          *(uint2*)(H0b + o) = pack4(v.x, v.y, v.z, v.w);
        }
      }
    }
  }
}

DI void phase_post(const Params& P, unsigned char* smem) {
  unsigned char* ws = P.ws;
  const int tid = otid();
  const float* Cs = (const float*)smem;
  const bf16_t* Sb = (const bf16_t*)(ws + OFF_S);
  const bf16_t* R = Sb;
  const bf16_t* V = Sb + (size_t)T * 512;
  const bf16_t* KD0 = Sb + (size_t)5 * T * 512;
  const bf16_t* KD1 = Sb + (size_t)6 * T * 512;
  const bf16_t* Y0 = (const bf16_t*)P.out;
  const bf16_t* Y1 = (const bf16_t*)P.out + (size_t)T * 512;
  const float* ln_w = P.in[14];
  const float* ln_b = P.in[15];
  const float* r_k = P.in[13];
  bf16_t* YA = (bf16_t*)(ws + OFF_YA);
  const bf16_t* AGD = (const bf16_t*)(ws + OFF_AGD);
  const bf16_t* G2T = (const bf16_t*)(ws + OFF_G2T);
  for (int item = blockIdx.x; item < 128 * 4; item += gridDim.x) {
    const int nt = item & 3, mt = item >> 2;
    const int m0 = mt * 128;
    f32x16 acc[2][2];
    zero_acc(acc);
    gemm_tile<false>(acc, AGD, 128, G2T + (size_t)nt * 128 * 128, 128, 128, m0, smem);
    stage_acc(acc, smem);
    const int gidx = tid >> 4, l16 = tid & 15;
#pragma unroll 2
    for (int it = 0; it < 16; ++it) {
      const int pair = gidx + 16 * it;
      const int row = pair >> 1, hsel = pair & 1;
      const int cl = hsel * 64 + l16 * 4;
      const int c = nt * 128 + cl;
      const size_t off = (size_t)(m0 + row) * 512 + c;
      float4 y0 = unpack4(*(const uint2*)(Y0 + off));
      float4 y1 = unpack4(*(const uint2*)(Y1 + off));
      float4 y = make_float4(y0.x + y1.x, y0.y + y1.y, y0.z + y1.z, y0.w + y1.w);
      float sm = y.x + y.y + y.z + y.w;
      sm = row16_sum(sm);
      const float mean = sm * (1.0f / 64.0f);
      y.x -= mean; y.y -= mean; y.z -= mean; y.w -= mean;
      float vs = y.x * y.x + y.y * y.y + y.z * y.z + y.w * y.w;
      vs = row16_sum(vs);
      const float rstd = rsqrtf(vs * (1.0f / 64.0f) + 64e-5f);
      float4 lw = *(const float4*)(ln_w + c);
      float4 lb = *(const float4*)(ln_b + c);
      float4 r = unpack4(*(const uint2*)(R + off));
      float4 k0 = unpack4(*(const uint2*)(KD0 + off));
      float4 k1 = unpack4(*(const uint2*)(KD1 + off));
      float4 v = unpack4(*(const uint2*)(V + off));
      float4 rk = *(const float4*)(r_k + c);
      float dt = r.x * (k0.x + k1.x) * rk.x + r.y * (k0.y + k1.y) * rk.y + r.z * (k0.z + k1.z) * rk.z + r.w * (k0.w + k1.w) * rk.w;
      dt = row16_sum(dt);
      float4 g = *(const float4*)(Cs + row * LDC + cl);
      float ox = (y.x * rstd * lw.x + lb.x + dt * v.x) * g.x;
      float oy = (y.y * rstd * lw.y + lb.y + dt * v.y) * g.y;
      float oz = (y.z * rstd * lw.z + lb.z + dt * v.z) * g.z;
      float ow = (y.w * rstd * lw.w + lb.w + dt * v.w) * g.w;
      *(uint2*)(YA + off) = pack4(ox, oy, oz, ow);
    }
  }
}

template <int HALF>
DI void wo_half(const Params& P, unsigned char* smem, float* rs_tile) {
  unsigned char* ws = P.ws;
  const int tid = otid(), lane = tid & 63, wave = tid >> 6;
  const float* Cs = (const float*)smem;
  const float* rstd0 = (const float*)(ws + OFF_SMALL);
  bf16_t* MG = (bf16_t*)(ws + OFF_MERGED);
  bf16_t* PART = (bf16_t*)(ws + OFF_HFF);
  const bf16_t* H0 = (const bf16_t*)P.out + (size_t)T * DM;
  const bf16_t* WinT = (const bf16_t*)(ws + OFF_WIN);
  const bf16_t* Yin = (const bf16_t*)(ws + (HALF ? OFF_YB : OFF_YA));
  const bf16_t* Wo = (const bf16_t*)(ws + (HALF ? OFF_WOB : OFF_WOA));
  const bool xmap = (gridDim.x == 512);
#pragma unroll 1
  for (int tile = blockIdx.x; tile < 128 * 8; tile += gridDim.x) {
    int nt = tile & 7, mt = tile >> 3;
    if (xmap) { const int x = tile & 7, j = tile >> 3, q = j & 63; nt = q >> 3; mt = x * 16 + (j >> 6) * 8 + (q & 7); }
    const int m0 = mt * 128, n0 = nt * 128;
    unsigned gp[2][2][8];
    {
      f32x16 accg[2][2];
      zero_acc(accg);
      gemm_tile<false, 0, false>(accg, H0, DM, WinT + (size_t)((HALF ? 4480 : 3456) + n0) * DM, DM, DM, m0, smem);
      const int wm = wave >> 1, hh = lane >> 5;
      if (tid < 128) rs_tile[tid] = rstd0[m0 + tid];
      __syncthreads();
      const float* rsp = rs_tile + wm * 64 + 4 * hh;
#pragma unroll
      for (int mi = 0; mi < 2; ++mi)
#pragma unroll
        for (int ni = 0; ni < 2; ++ni)
#pragma unroll
          for (int i = 0; i < 16; i += 2) {
            const float rs0 = rsp[mi * 32 + (i & 3) + 8 * (i >> 2)];
            const float rs1 = rsp[mi * 32 + ((i + 1) & 3) + 8 * ((i + 1) >> 2)];
            gp[mi][ni][i >> 1] = pack2(sigmoidf_(rs0 * accg[mi][ni][i]), sigmoidf_(rs1 * accg[mi][ni][i + 1]));
          }
    }
    f32x16 accv[2][2];
    zero_acc(accv);
    gemm_tile<false, 0, false>(accv, Yin, 512, Wo + (size_t)n0 * 512, 512, 512, m0, smem);
#pragma unroll
    for (int mi = 0; mi < 2; ++mi)
#pragma unroll
      for (int ni = 0; ni < 2; ++ni)
#pragma unroll
        for (int i = 0; i < 16; i += 2) {
          const unsigned g = gp[mi][ni][i >> 1];
          accv[mi][ni][i] *= bf2f(g & 0xffffu);
          accv[mi][ni][i + 1] *= bf2f(g >> 16);
        }
    stage_acc(accv, smem);
#pragma unroll 2
    for (int it = 0; it < 16; ++it) {
      int idx = tid + 256 * it, row = idx >> 5, c4 = (idx & 31) * 4;
      const size_t off = (size_t)(m0 + row) * DM + n0 + c4;
      float4 c = *(const float4*)(Cs + row * LDC + c4);
      if (HALF == 0) {
        *(uint2*)(PART + off) = pack4(c.x, c.y, c.z, c.w);
      } else {
        float4 a = unpack4(*(const uint2*)(PART + off));
        *(uint2*)(MG + off) = pack4(a.x + c.x, a.y + c.y, a.z + c.z, a.w + c.w);
      }
    }
  }
}
DI void phase_wo(const Params& P, unsigned char* smem, float* rs_tile) {
  wo_half<0>(P, smem, rs_tile);
  wo_half<1>(P, smem, rs_tile);
}

DI void resid_epilogue(const float* Cs, const float* xi, float* xo, bf16_t* xb, float* ss, int m0, int n0, bool write_xb, const float* mul = nullptr) {
  const int tid = otid();
#pragma unroll 4
  for (int it = 0; it < 16; ++it) {
    int idx = tid + 256 * it, row = idx >> 5, c4 = (idx & 31) * 4;
    size_t off = (size_t)(m0 + row) * DM + n0 + c4;
    float4 a = *(const float4*)(xi + off);
    float4 c = *(const float4*)(Cs + row * LDC + c4);
    if (mul) { float4 g = *(const float4*)(mul + off); c.x *= g.x; c.y *= g.y; c.z *= g.z; c.w *= g.w; }
    float4 o = make_float4(a.x + c.x, a.y + c.y, a.z + c.z, a.w + c.w);
    *(float4*)(xo + off) = o;
    if (write_xb) *(uint2*)(xb + off) = pack4(o.x, o.y, o.z, o.w);
    float s = o.x * o.x + o.y * o.y + o.z * o.z + o.w * o.w;
    s = half32_sum(s);
    if ((tid & 31) == 0) atomicAdd(ss + m0 + row, s);
  }
}

DI void phase_wout(const Params& P, unsigned char* smem) {
  unsigned char* ws = P.ws;
  const float* Cs = (const float*)smem;
  float* small = (float*)(ws + OFF_SMALL);
  const bf16_t* MG = (const bf16_t*)(ws + OFF_MERGED);
  const bf16_t* WoutT = (const bf16_t*)(ws + OFF_WOUT);
  const bool xmap = (gridDim.x == 512);
#pragma unroll 1
  for (int tile = blockIdx.x; tile < 64 * 8; tile += gridDim.x) {
    int nt = tile & 7, mt = tile >> 3;
    if (xmap) { const int x = tile & 7, j = tile >> 3; nt = j >> 3; mt = x * 8 + (j & 7); }
    const int m0 = mt * 256, n0 = nt * 128;
    f32x16 acc[4][2];
    zero_acc256(acc);
    gemm_tile256(acc, MG, DM, WoutT + (size_t)n0 * DM, DM, DM, m0, smem);
#pragma unroll 1
    for (int hsel = 0; hsel < 2; ++hsel) {
      stage_half(acc, hsel, smem);
      resid_epilogue(Cs, P.in[0], P.out, (bf16_t*)(ws + OFF_XB), small + T, m0 + hsel * 128, n0, true);
      __syncthreads();
    }
  }
}

DI void phase_ff1(const Params& P, unsigned char* smem) {
  unsigned char* ws = P.ws;
  const int tid = otid();
  const float* Cs = (const float*)smem;
  const float* ss1 = (const float*)(ws + OFF_SMALL) + T;
  const bf16_t* XB = (const bf16_t*)(ws + OFF_XB);
  const bf16_t* W1T = (const bf16_t*)(ws + OFF_W1);
  bf16_t* HFF = (bf16_t*)(ws + OFF_HFF);
  const bool xmap = (gridDim.x == 512);
#pragma unroll 1
  for (int tile = blockIdx.x; tile < 64 * 32; tile += gridDim.x) {
    int nt = tile & 31, mt = tile >> 5;
    if (xmap) { const int x = tile & 7, j = tile >> 3, q = j & 63; nt = (j >> 6) * 8 + (q >> 3); mt = x * 8 + (q & 7); }
    const int m0 = mt * 256, n0 = nt * 128;
    f32x16 acc[4][2];
    zero_acc256(acc);
    gemm_tile256(acc, XB, DM, W1T + (size_t)n0 * DM, DM, DM, m0, smem);
#pragma unroll 1
    for (int hsel = 0; hsel < 2; ++hsel) {
      stage_half(acc, hsel, smem);
      const int mh = m0 + hsel * 128;
#pragma unroll 4
      for (int it = 0; it < 16; ++it) {
        int idx = tid + 256 * it, row = idx >> 5, c4 = (idx & 31) * 4;
        float rs = rsqrtf(ss1[mh + row] * (1.0f / 1024.0f) + 1e-6f);
        float4 c = *(const float4*)(Cs + row * LDC + c4);
        float hx = fmaxf(c.x * rs, 0.f), hy = fmaxf(c.y * rs, 0.f), hz = fmaxf(c.z * rs, 0.f), hw = fmaxf(c.w * rs, 0.f);
        *(uint2*)(HFF + (size_t)(mh + row) * 4096 + n0 + c4) = pack4(hx * hx, hy * hy, hz * hz, hw * hw);
      }
      __syncthreads();
    }
  }
}

DI void phase_ff2(const Params& P, unsigned char* smem) {
  unsigned char* ws = P.ws;
  const float* Cs = (const float*)smem;
  float* small = (float*)(ws + OFF_SMALL);
  const bf16_t* HFF = (const bf16_t*)(ws + OFF_HFF);
  const bf16_t* W2T = (const bf16_t*)(ws + OFF_W2F);
  const bool xmap = (gridDim.x == 512);
#pragma unroll 1
  for (int tile = blockIdx.x; tile < 64 * 8; tile += gridDim.x) {
    int nt = tile & 7, mt = tile >> 3;
    if (xmap) { const int x = tile & 7, j = tile >> 3; nt = j >> 3; mt = x * 8 + (j & 7); }
    const int m0 = mt * 256, n0 = nt * 128;
    f32x16 acc[4][2];
    zero_acc256(acc);
    gemm_tile256(acc, HFF, 4096, W2T + (size_t)n0 * 4096, 4096, 4096, m0, smem);
#pragma unroll 1
    for (int hsel = 0; hsel < 2; ++hsel) {
      stage_half(acc, hsel, smem);
      resid_epilogue(Cs, P.out, P.out, (bf16_t*)(ws + OFF_XB), small + 2 * T, m0 + hsel * 128, n0, true);
      __syncthreads();
    }
  }
}

DI void phase_ple(const Params& P, unsigned char* smem, float* rs_tile) {
  unsigned char* ws = P.ws;
  const int tid = otid(), lane = tid & 63, wave = tid >> 6;
  const float* Cs = (const float*)smem;
  float* small = (float*)(ws + OFF_SMALL);
  const bf16_t* XB = (const bf16_t*)(ws + OFF_XB);
  const bf16_t* WpgT = (const bf16_t*)(ws + OFF_WPG);
  const bf16_t* WppT = (const bf16_t*)(ws + OFF_WPP);
  const float* ss2 = small + 2 * T;
  const bool xmap = (gridDim.x == 512);
#pragma unroll 1
  for (int tile = blockIdx.x; tile < 128 * 8; tile += gridDim.x) {
    int nt = tile & 7, mt = tile >> 3;
    if (xmap) { const int x = tile & 7, j = tile >> 3, q = j & 63; nt = q >> 3; mt = x * 16 + (j >> 6) * 8 + (q & 7); }
    const int m0 = mt * 128, n0 = nt * 128;
    unsigned gp[2][2][8];
    {
      f32x16 accg[2][2];
      zero_acc(accg);
      gemm_tile<false, 0, false>(accg, XB, DM, WpgT + (size_t)n0 * DM, DM, DM, m0, smem);
      const int wm = wave >> 1, hh = lane >> 5;
      if (tid < 128) rs_tile[tid] = rsqrtf(ss2[m0 + tid] * (1.0f / 1024.0f) + 1e-6f);
      __syncthreads();
      const float* rsp = rs_tile + wm * 64 + 4 * hh;
#pragma unroll
      for (int mi = 0; mi < 2; ++mi)
#pragma unroll
        for (int ni = 0; ni < 2; ++ni)
#pragma unroll
          for (int i = 0; i < 16; i += 2) {
            const float rs0 = rsp[mi * 32 + (i & 3) + 8 * (i >> 2)];
            const float rs1 = rsp[mi * 32 + ((i + 1) & 3) + 8 * ((i + 1) >> 2)];
            gp[mi][ni][i >> 1] = pack2(sigmoidf_(rs0 * accg[mi][ni][i]), sigmoidf_(rs1 * accg[mi][ni][i + 1]));
          }
    }
    f32x16 accv[2][2];
    zero_acc(accv);
    gemm_tile<true>(accv, P.in[1], 256, WppT + (size_t)n0 * 256, 256, 256, m0, smem);
#pragma unroll
    for (int mi = 0; mi < 2; ++mi)
#pragma unroll
      for (int ni = 0; ni < 2; ++ni)
#pragma unroll
        for (int i = 0; i < 16; i += 2) {
          const unsigned g = gp[mi][ni][i >> 1];
          accv[mi][ni][i] *= bf2f(g & 0xffffu);
          accv[mi][ni][i + 1] *= bf2f(g >> 16);
        }
    stage_acc(accv, smem);
    resid_epilogue(Cs, P.out, P.out, nullptr, small + 3 * T, m0, n0, false);
  }
}

DI void phase_final(const Params& P) {
  const float* ss3 = (const float*)(P.ws + OFF_SMALL) + 3 * T;
  const float* g = P.in[30];
  const size_t n4 = (size_t)T * DM / 4;
  for (size_t i = (size_t)blockIdx.x * NTHREADS + threadIdx.x; i < n4; i += (size_t)gridDim.x * NTHREADS) {
    const int row = (int)(i >> 8);
    const int c = (int)(i & 255) * 4;
    const float rs = rsqrtf(ss3[row] * (1.0f / 1024.0f) + 1e-6f);
    float4 v = *(const float4*)(P.out + i * 4);
    float4 gg = *(const float4*)(g + c);
    v.x *= rs * gg.x; v.y *= rs * gg.y; v.z *= rs * gg.z; v.w *= rs * gg.w;
    *(float4*)(P.out + i * 4) = v;
  }
}

#define XB_TMO      128
#define XB_XCNT(j)  (256  + 64 * (j))
#define XB_XSUB(j)  (1280 + 64 * (j))
#define XB_XGEN(j)  (2304 + 64 * (j))
#define XB_TOP      3328
#define XB_TOPGEN   3392
#define XCD_BAR_WORDS 3456
#define XB_SPIN_CAP (1u << 20)
#define LAS __attribute__((address_space(3)))
constexpr size_t OFF_BAR = OFF_SMALL + 524288;

DI unsigned xb_ld(unsigned* p) { return __hip_atomic_load(p, __ATOMIC_RELAXED, __HIP_MEMORY_SCOPE_AGENT); }
DI unsigned xb_add(unsigned* p, unsigned v) { return __hip_atomic_fetch_add(p, v, __ATOMIC_RELAXED, __HIP_MEMORY_SCOPE_AGENT); }
DI unsigned xb_xcc_id() { return (unsigned)__builtin_amdgcn_s_getreg((3 << 11) | 20) & 0xFu; }
#define XB_SPIN(cond, bar) do { unsigned _sp = 0; while (cond) { __builtin_amdgcn_s_sleep(1); \
    if ((++_sp & 255u) == 0u) { if (xb_ld(&(bar)[XB_TMO])) break; if (_sp > XB_SPIN_CAP) { atomicAdd(&(bar)[XB_TMO], 1u); break; } } } } while (0)

struct XcdBarrier { unsigned* bar; unsigned x; volatile unsigned* st; };

DI XcdBarrier xcd_barrier_post(unsigned* bar, volatile unsigned* st) {
  XcdBarrier b; b.bar = bar; b.x = xb_xcc_id(); b.st = st;
  if (threadIdx.x == 0) (void)xb_add(&bar[XB_XCNT(b.x)], 1u);
  return b;
}
DI void xcd_barrier_complete(unsigned* bar, unsigned x, unsigned& nloc, unsigned& nx) {
  const unsigned G = gridDim.x * gridDim.y * gridDim.z;
  unsigned sum, cnt, mine, sp = 0u;
  for (;;) {
    sum = 0u; cnt = 0u; mine = 0u;
#pragma unroll
    for (unsigned j = 0; j < 16; ++j) { const unsigned c = xb_ld(&bar[XB_XCNT(j)]); sum += c; cnt += (c > 0u) ? 1u : 0u; mine = (j == x) ? c : mine; }
    if (sum == G) break;
    __builtin_amdgcn_s_sleep(1);
    if ((++sp & 255u) == 0u) { if (xb_ld(&bar[XB_TMO])) break; if (sp > XB_SPIN_CAP) { atomicAdd(&bar[XB_TMO], 1u); break; } }
  }
  nloc = mine > 0u ? mine : 1u; nx = cnt > 0u ? cnt : 1u;
}
DI void xcd_barrier(const XcdBarrier& b) {
  asm volatile("s_waitcnt vmcnt(0)" ::: "memory");
  __syncthreads();
  if (threadIdx.x == 0) {
    unsigned* bar = b.bar;
    __builtin_amdgcn_s_waitcnt(0);
    unsigned nloc = b.st[0], nx = b.st[1];
    if (nloc == 0u) { xcd_barrier_complete(bar, b.x, nloc, nx); b.st[0] = nloc; b.st[1] = nx; }
    const unsigned old = xb_add(&bar[XB_XSUB(b.x)], 1u);
    const unsigned gen = old / nloc;
    if (old + 1u == (gen + 1u) * nloc) {
      __builtin_amdgcn_fence(__ATOMIC_RELEASE, "agent");
      asm volatile("s_waitcnt vmcnt(0)" ::: "memory");
      const unsigned og = xb_add(&bar[XB_TOP], 1u);
      const unsigned tg = og / nx;
      if (og + 1u == (tg + 1u) * nx) xb_add(&bar[XB_TOPGEN], 1u);
      else XB_SPIN(xb_ld(&bar[XB_TOPGEN]) == tg, bar);
      __builtin_amdgcn_fence(__ATOMIC_ACQUIRE, "agent");
      xb_add(&bar[XB_XGEN(b.x)], 1u);
      asm volatile("s_waitcnt vmcnt(0)" ::: "memory");
    } else {
      XB_SPIN(xb_ld(&bar[XB_XGEN(b.x)]) == gen, bar);
      __builtin_amdgcn_fence(__ATOMIC_ACQUIRE, "agent");
      asm volatile("s_waitcnt vmcnt(0)" ::: "memory");
    }
  }
  __syncthreads();
}

__global__ void __launch_bounds__(NTHREADS, 2) fwd_megakernel(Params P) {
  __shared__ __attribute__((aligned(16))) unsigned char smem[SMEM_BYTES];
  __shared__ int s_item[2];
  __shared__ float rs_tile[128];
  __shared__ uint4 xb_words;
  cg::grid_group grid = cg::this_grid();
  if (P.ws == nullptr) grid.sync();
  if (threadIdx.x == 0) xb_words = make_uint4(0u, 0u, 0u, 0u);
  __syncthreads();
  const XcdBarrier xb = xcd_barrier_post((unsigned*)(P.ws + OFF_BAR), (volatile unsigned*)&xb_words);
  phase_prep(P, smem);
  xcd_barrier(xb);
  phase_p1(P, smem);
  xcd_barrier(xb);
  phase_e1(P);
  xcd_barrier(xb);
  phase_lora(P, smem);
  xcd_barrier(xb);
  phase_mix(P, smem, s_item);
  xcd_barrier(xb);
  phase_post(P, smem);
  xcd_barrier(xb);
  phase_wo(P, smem, rs_tile);
  xcd_barrier(xb);
  phase_wout(P, smem);
  xcd_barrier(xb);
  phase_ff1(P, smem);
  xcd_barrier(xb);
  phase_ff2(P, smem);
  xcd_barrier(xb);
  phase_ple(P, smem, rs_tile);
  xcd_barrier(xb);
  phase_final(P);
}

extern "C" void kernel_launch(void* const* d_in, const int* in_sizes, int n_in, void* d_out, int out_size,
                              void* d_ws, size_t ws_size, hipStream_t stream) {
  static int grid_blocks = 0;
  if (!grid_blocks) {
    int dev = 0, cus = 0, per_cu = 0;
    hipGetDevice(&dev);
    hipDeviceGetAttribute(&cus, hipDeviceAttributeMultiprocessorCount, dev);
    hipOccupancyMaxActiveBlocksPerMultiprocessor(&per_cu, fwd_megakernel, NTHREADS, 0);
    if (per_cu > 2) per_cu = 2;
    if (per_cu < 1) per_cu = 1;
    grid_blocks = cus * per_cu;
  }
  Params p{};
  for (int i = 0; i < 31; ++i) p.in[i] = (const float*)d_in[i];
  p.out = (float*)d_out;
  p.ws = (unsigned char*)d_ws;
  hipMemsetAsync((unsigned char*)d_ws + OFF_BAR, 0, XCD_BAR_WORDS * sizeof(unsigned), stream);
  void* args[] = {&p};
  hipError_t e = hipLaunchCooperativeKernel((void*)fwd_megakernel, dim3(grid_blocks), dim3(NTHREADS), args, 0, stream);
  if (e != hipSuccess) fprintf(stderr, "cooperative launch failed: %s (grid %d)\n", hipGetErrorString(e), grid_blocks);
}
```

```cpp
#include <hip/hip_runtime.h>
#include <hip/hip_cooperative_groups.h>
#include <cstdio>
namespace cg = cooperative_groups;

#define DI __device__ __forceinline__
typedef __attribute__((ext_vector_type(8))) short bf16x8;
typedef __attribute__((ext_vector_type(4))) short s16x4;
typedef __attribute__((ext_vector_type(16))) float f32x16;
typedef unsigned short bf16_t;
typedef unsigned u32x4 __attribute__((ext_vector_type(4)));

#define MFMA32(a, b, c) __builtin_amdgcn_mfma_f32_32x32x16_bf16((a), (b), (c), 0, 0, 0)

constexpr int T = 16384;
constexpr int SEQ = 8192;
constexpr int DM = 1024;
constexpr int NTHREADS = 256;

constexpr size_t OFF_WIN = 0;
constexpr size_t OFF_W1 = 11272192;
constexpr size_t OFF_W2F = 19660800;
constexpr size_t OFF_WOUT = 28049408;
constexpr size_t OFF_WPG = 30146560;
constexpr size_t OFF_WPP = 32243712;
constexpr size_t OFF_WOA = 32768000;
constexpr size_t OFF_WOB = 33816576;
constexpr size_t OFF_W2T = 34865152;
constexpr size_t OFF_A2T = 34996224;
constexpr size_t OFF_G2T = 35127296;
constexpr size_t OFF_SMALL = 35258368;
constexpr size_t OFF_S = 36306944;
constexpr size_t SLOT = 16777216;
constexpr size_t OFF_Q = 187301888;
constexpr size_t OFF_K = 204079104;
constexpr size_t OFF_VT = 220856320;
constexpr size_t OFF_AWD = 237633536;
constexpr size_t OFF_AAD = 241827840;
constexpr size_t OFF_AGD = 246022144;
constexpr size_t OFF_YB = 250216448;
constexpr size_t OFF_KTMP = OFF_YB;
constexpr size_t OFF_YA = OFF_Q;
constexpr size_t OFF_MERGED = OFF_K;
constexpr size_t OFF_XB = OFF_S;
constexpr size_t OFF_HFF = OFF_S + 33554432;
constexpr size_t OFF_H0 = OFF_S + 7 * SLOT;

struct Params {
  const float* in[31];
  float* out;
  unsigned char* ws;
};

DI bf16_t f2bf(float x) {
  unsigned u = __float_as_uint(x);
  u += 0x7fffu + ((u >> 16) & 1u);
  return (bf16_t)(u >> 16);
}
DI float bf2f(unsigned b) { return __uint_as_float(b << 16); }
typedef __bf16 bf16x2v __attribute__((ext_vector_type(2)));
typedef float f32x2v __attribute__((ext_vector_type(2)));
DI unsigned pack2(float a, float b) {
  f32x2v f = {a, b};
  bf16x2v r = __builtin_convertvector(f, bf16x2v);
  return __builtin_bit_cast(unsigned, r);
}
DI uint2 pack4(float a, float b, float c, float d) { return make_uint2(pack2(a, b), pack2(c, d)); }
DI float4 unpack4(uint2 v) {
  return make_float4(bf2f(v.x & 0xffffu), bf2f(v.x >> 16), bf2f(v.y & 0xffffu), bf2f(v.y >> 16));
}
DI float sigmoidf_(float x) { return 1.0f / (1.0f + __expf(-x)); }
DI unsigned xb_xcc_id();
DI int otid() { int t = threadIdx.x; asm volatile("" : "+v"(t)); return t; }
DI int crow(int i, int hh) { return (i & 3) + 8 * (i >> 2) + 4 * hh; }

template <int CTRL>
DI float dpp_add(float p) {
  int q = __builtin_amdgcn_update_dpp(0, __float_as_int(p), CTRL, 0xf, 0xf, false);
  return p + __int_as_float(q);
}
DI float row16_sum(float p) {
  p = dpp_add<0x128>(p);
  p = dpp_add<0x124>(p);
  p = dpp_add<0x122>(p);
  p = dpp_add<0x121>(p);
  return p;
}
DI float xor32_sum(float v) {
  auto r = __builtin_amdgcn_permlane32_swap(__float_as_uint(v), __float_as_uint(v), false, false);
  return __uint_as_float(r[0]) + __uint_as_float(r[1]);
}
DI float xor32_max(float v) {
  auto r = __builtin_amdgcn_permlane32_swap(__float_as_uint(v), __float_as_uint(v), false, false);
  return fmaxf(__uint_as_float(r[0]), __uint_as_float(r[1]));
}
DI float half32_sum(float v) {
  v = row16_sum(v);
  auto r = __builtin_amdgcn_permlane16_swap(__float_as_uint(v), __float_as_uint(v), false, false);
  return __uint_as_float(r[0]) + __uint_as_float(r[1]);
}
DI float wave_sum(float v) { return xor32_sum(half32_sum(v)); }

constexpr int LDT = 72;
constexpr int LDC = 132;
constexpr int SMEM_BYTES = 2 * 2 * 128 * LDT * 2;

template <bool AF32, int PROBE = 0, bool PF2 = true>
DI void gemm_tile(f32x16 (&acc)[2][2], const void* __restrict__ Aptr, int lda,
                  const bf16_t* __restrict__ Bt, int ldb, int K, int m0, unsigned char* smem) {
  const int tid = otid(), lane = tid & 63, wave = tid >> 6;
  const int wm = wave >> 1, wn = wave & 1;
  bf16_t* As = (bf16_t*)smem;
  bf16_t* Bs = As + 2 * 128 * LDT;
  const int nk = K >> 6;
  const bf16_t* A16 = (const bf16_t*)Aptr;
  const float* A32 = (const float*)Aptr;
  const unsigned aoff32 = AF32 ? (unsigned)((tid >> 4) * lda + (tid & 15) * 4) : (unsigned)((tid >> 3) * lda + (tid & 7) * 8);
  const unsigned boff32 = (unsigned)((tid >> 3) * ldb + (tid & 7) * 8);
  const float* A32b = A32 + (size_t)m0 * lda;
  const bf16_t* A16b = A16 + (size_t)m0 * lda;
#define GL32(p, kt_) { \
    const float* ab_ = A32b + (kt_) * 64; \
    p##f0 = *(const float4*)((ab_ + 0 * 16 * lda) + aoff32); \
    p##f1 = *(const float4*)((ab_ + 1 * 16 * lda) + aoff32); \
    p##f2 = *(const float4*)((ab_ + 2 * 16 * lda) + aoff32); \
    p##f3 = *(const float4*)((ab_ + 3 * 16 * lda) + aoff32); \
    p##f4 = *(const float4*)((ab_ + 4 * 16 * lda) + aoff32); \
    p##f5 = *(const float4*)((ab_ + 5 * 16 * lda) + aoff32); \
    p##f6 = *(const float4*)((ab_ + 6 * 16 * lda) + aoff32); \
    p##f7 = *(const float4*)((ab_ + 7 * 16 * lda) + aoff32); \
    const bf16_t* bb_ = Bt + (kt_) * 64; \
    p##b0 = *(const uint4*)((bb_ + 0 * 32 * ldb) + boff32); \
    p##b1 = *(const uint4*)((bb_ + 1 * 32 * ldb) + boff32); \
    p##b2 = *(const uint4*)((bb_ + 2 * 32 * ldb) + boff32); \
    p##b3 = *(const uint4*)((bb_ + 3 * 32 * ldb) + boff32); }
#define GL16(p, kt_) { \
    const bf16_t* ab_ = A16b + (kt_) * 64; \
    p##a0 = *(const uint4*)((ab_ + 0 * 32 * lda) + aoff32); \
    p##a1 = *(const uint4*)((ab_ + 1 * 32 * lda) + aoff32); \
    p##a2 = *(const uint4*)((ab_ + 2 * 32 * lda) + aoff32); \
    p##a3 = *(const uint4*)((ab_ + 3 * 32 * lda) + aoff32); \
    const bf16_t* bb_ = Bt + (kt_) * 64; \
    p##b0 = *(const uint4*)((bb_ + 0 * 32 * ldb) + boff32); \
    p##b1 = *(const uint4*)((bb_ + 1 * 32 * ldb) + boff32); \
    p##b2 = *(const uint4*)((bb_ + 2 * 32 * ldb) + boff32); \
    p##b3 = *(const uint4*)((bb_ + 3 * 32 * ldb) + boff32); }
#define SW32(p, buf_) { \
    bf16_t* d_ = As + (buf_) * 128 * LDT + (tid >> 4) * LDT + (tid & 15) * 4; \
    *(uint2*)(d_ + 0 * 16 * LDT) = pack4(p##f0.x, p##f0.y, p##f0.z, p##f0.w); \
    *(uint2*)(d_ + 1 * 16 * LDT) = pack4(p##f1.x, p##f1.y, p##f1.z, p##f1.w); \
    *(uint2*)(d_ + 2 * 16 * LDT) = pack4(p##f2.x, p##f2.y, p##f2.z, p##f2.w); \
    *(uint2*)(d_ + 3 * 16 * LDT) = pack4(p##f3.x, p##f3.y, p##f3.z, p##f3.w); \
    *(uint2*)(d_ + 4 * 16 * LDT) = pack4(p##f4.x, p##f4.y, p##f4.z, p##f4.w); \
    *(uint2*)(d_ + 5 * 16 * LDT) = pack4(p##f5.x, p##f5.y, p##f5.z, p##f5.w); \
    *(uint2*)(d_ + 6 * 16 * LDT) = pack4(p##f6.x, p##f6.y, p##f6.z, p##f6.w); \
    *(uint2*)(d_ + 7 * 16 * LDT) = pack4(p##f7.x, p##f7.y, p##f7.z, p##f7.w); \
    bf16_t* d2_ = Bs + (buf_) * 128 * LDT + (tid >> 3) * LDT + (tid & 7) * 8; \
    *(uint4*)(d2_ + 0 * 32 * LDT) = p##b0; *(uint4*)(d2_ + 1 * 32 * LDT) = p##b1; \
    *(uint4*)(d2_ + 2 * 32 * LDT) = p##b2; *(uint4*)(d2_ + 3 * 32 * LDT) = p##b3; }
#define SW16(p, buf_) { \
    bf16_t* d_ = As + (buf_) * 128 * LDT + (tid >> 3) * LDT + (tid & 7) * 8; \
    *(uint4*)(d_ + 0 * 32 * LDT) = p##a0; *(uint4*)(d_ + 1 * 32 * LDT) = p##a1; \
    *(uint4*)(d_ + 2 * 32 * LDT) = p##a2; *(uint4*)(d_ + 3 * 32 * LDT) = p##a3; \
    bf16_t* d2_ = Bs + (buf_) * 128 * LDT + (tid >> 3) * LDT + (tid & 7) * 8; \
    *(uint4*)(d2_ + 0 * 32 * LDT) = p##b0; *(uint4*)(d2_ + 1 * 32 * LDT) = p##b1; \
    *(uint4*)(d2_ + 2 * 32 * LDT) = p##b2; *(uint4*)(d2_ + 3 * 32 * LDT) = p##b3; }
  auto compute = [&](int buf) __attribute__((always_inline)) {
    const bf16_t* as = As + buf * 128 * LDT + (wm * 64 + (lane & 31)) * LDT + (lane >> 5) * 8;
    const bf16_t* bs = Bs + buf * 128 * LDT + (wn * 64 + (lane & 31)) * LDT + (lane >> 5) * 8;
#pragma unroll
    for (int ks = 0; ks < 4; ++ks) {
      bf16x8 a0 = *(const bf16x8*)(as + ks * 16);
      bf16x8 a1 = *(const bf16x8*)(as + 32 * LDT + ks * 16);
      bf16x8 b0 = *(const bf16x8*)(bs + ks * 16);
      bf16x8 b1 = *(const bf16x8*)(bs + 32 * LDT + ks * 16);
      acc[0][0] = MFMA32(a0, b0, acc[0][0]);
      acc[0][1] = MFMA32(a0, b1, acc[0][1]);
      acc[1][0] = MFMA32(a1, b0, acc[1][0]);
      acc[1][1] = MFMA32(a1, b1, acc[1][1]);
    }
  };
  __syncthreads();
  if (AF32) {
    float4 sf0, sf1, sf2, sf3, sf4, sf5, sf6, sf7;
    uint4 sb0, sb1, sb2, sb3;
    GL32(s, 0);
    SW32(s, 0);
    __syncthreads();
#pragma unroll 1
    for (int kt = 0; kt < nk - 1; ++kt) {
      const int buf = kt & 1;
      GL32(s, kt + 1);
      __builtin_amdgcn_sched_barrier(0);
      compute(buf);
      SW32(s, buf ^ 1);
      __syncthreads();
    }
    compute((nk - 1) & 1);
    __syncthreads();
  } else if (!PF2) {
    uint4 pa0, pa1, pa2, pa3, pb0, pb1, pb2, pb3;
    GL16(p, 0);
    SW16(p, 0);
    __syncthreads();
#pragma unroll 1
    for (int kt = 0; kt < nk - 1; ++kt) {
      const int buf = kt & 1;
      GL16(p, kt + 1);
      __builtin_amdgcn_sched_barrier(0);
      compute(buf);
      SW16(p, buf ^ 1);
      __syncthreads();
    }
    compute((nk - 1) & 1);
    __syncthreads();
  } else {
    uint4 pa0, pa1, pa2, pa3, pb0, pb1, pb2, pb3;
    uint4 qa0, qa1, qa2, qa3, qb0, qb1, qb2, qb3;
    GL16(p, 0);
    if (nk > 1) GL16(q, 1);
    SW16(p, 0);
    __syncthreads();
    int kt = 0;
#pragma unroll 1
    for (; kt + 2 < nk; kt += 2) {
      GL16(p, kt + 2);
      __builtin_amdgcn_sched_barrier(0);
      compute(0);
      SW16(q, 1);
      __syncthreads();
      if (kt + 3 < nk) GL16(q, kt + 3);
      __builtin_amdgcn_sched_barrier(0);
      compute(1);
      SW16(p, 0);
      __syncthreads();
    }
    if (kt + 1 < nk) {
      compute(0);
      SW16(q, 1);
      __syncthreads();
      compute(1);
      __syncthreads();
    } else {
      compute(0);
      __syncthreads();
    }
  }
#undef GL32
#undef GL16
#undef SW32
#undef SW16
}

DI void zero_acc(f32x16 (&acc)[2][2]) {
#pragma unroll
  for (int a = 0; a < 2; ++a)
#pragma unroll
    for (int b = 0; b < 2; ++b)
#pragma unroll
      for (int i = 0; i < 16; ++i) acc[a][b][i] = 0.f;
}

DI void stage_acc(const f32x16 (&acc)[2][2], unsigned char* smem) {
  const int tid = otid(), lane = tid & 63, wave = tid >> 6;
  const int wm = wave >> 1, wn = wave & 1, hh = lane >> 5;
  float* Cs = (float*)smem;
#pragma unroll
  for (int mi = 0; mi < 2; ++mi)
#pragma unroll
    for (int ni = 0; ni < 2; ++ni)
#pragma unroll
      for (int i = 0; i < 16; ++i)
        Cs[(wm * 64 + mi * 32 + crow(i, hh)) * LDC + wn * 64 + ni * 32 + (lane & 31)] = acc[mi][ni][i];
  __syncthreads();
}

DI void gemm_tile256(f32x16 (&acc)[4][2], const bf16_t* __restrict__ A16, int lda,
                     const bf16_t* __restrict__ Bt, int ldb, int K, int m0, unsigned char* smem) {
  const int tid = otid(), lane = tid & 63, wave = tid >> 6;
  const int wm = wave >> 1, wn = wave & 1;
  bf16_t* As = (bf16_t*)smem;
  bf16_t* Bs = As + 256 * LDT;
  const int nk = K >> 6;
  const unsigned aoff32 = (unsigned)((tid >> 3) * lda + (tid & 7) * 8);
  const unsigned boff32 = (unsigned)((tid >> 3) * ldb + (tid & 7) * 8);
  const bf16_t* A16b = A16 + (size_t)m0 * lda;
  uint4 a0, a1, a2, a3, a4, a5, a6, a7, b0, b1, b2, b3;
#define GL256(kt_) { \
    const bf16_t* ab_ = A16b + (kt_) * 64; \
    a0 = *(const uint4*)((ab_ + 0 * 32 * lda) + aoff32); \
    a1 = *(const uint4*)((ab_ + 1 * 32 * lda) + aoff32); \
    a2 = *(const uint4*)((ab_ + 2 * 32 * lda) + aoff32); \
    a3 = *(const uint4*)((ab_ + 3 * 32 * lda) + aoff32); \
    a4 = *(const uint4*)((ab_ + 4 * 32 * lda) + aoff32); \
    a5 = *(const uint4*)((ab_ + 5 * 32 * lda) + aoff32); \
    a6 = *(const uint4*)((ab_ + 6 * 32 * lda) + aoff32); \
    a7 = *(const uint4*)((ab_ + 7 * 32 * lda) + aoff32); \
    const bf16_t* bb_ = Bt + (kt_) * 64; \
    b0 = *(const uint4*)((bb_ + 0 * 32 * ldb) + boff32); \
    b1 = *(const uint4*)((bb_ + 1 * 32 * ldb) + boff32); \
    b2 = *(const uint4*)((bb_ + 2 * 32 * ldb) + boff32); \
    b3 = *(const uint4*)((bb_ + 3 * 32 * ldb) + boff32); }
#define SW256() { \
    bf16_t* d_ = As + (tid >> 3) * LDT + (tid & 7) * 8; \
    *(uint4*)(d_ + 0 * 32 * LDT) = a0; *(uint4*)(d_ + 1 * 32 * LDT) = a1; \
    *(uint4*)(d_ + 2 * 32 * LDT) = a2; *(uint4*)(d_ + 3 * 32 * LDT) = a3; \
    *(uint4*)(d_ + 4 * 32 * LDT) = a4; *(uint4*)(d_ + 5 * 32 * LDT) = a5; \
    *(uint4*)(d_ + 6 * 32 * LDT) = a6; *(uint4*)(d_ + 7 * 32 * LDT) = a7; \
    bf16_t* d2_ = Bs + (tid >> 3) * LDT + (tid & 7) * 8; \
    *(uint4*)(d2_ + 0 * 32 * LDT) = b0; *(uint4*)(d2_ + 1 * 32 * LDT) = b1; \
    *(uint4*)(d2_ + 2 * 32 * LDT) = b2; *(uint4*)(d2_ + 3 * 32 * LDT) = b3; }
  auto compute = [&]() __attribute__((always_inline)) {
    const bf16_t* as = As + (wm * 128 + (lane & 31)) * LDT + (lane >> 5) * 8;
    const bf16_t* bs = Bs + (wn * 64 + (lane & 31)) * LDT + (lane >> 5) * 8;
#pragma unroll
    for (int ks = 0; ks < 4; ++ks) {
      bf16x8 fb0 = *(const bf16x8*)(bs + ks * 16);
      bf16x8 fb1 = *(const bf16x8*)(bs + 32 * LDT + ks * 16);
      bf16x8 fa0 = *(const bf16x8*)(as + ks * 16);
      bf16x8 fa1 = *(const bf16x8*)(as + 32 * LDT + ks * 16);
      bf16x8 fa2 = *(const bf16x8*)(as + 64 * LDT + ks * 16);
      bf16x8 fa3 = *(const bf16x8*)(as + 96 * LDT + ks * 16);
      acc[0][0] = MFMA32(fa0, fb0, acc[0][0]);
      acc[0][1] = MFMA32(fa0, fb1, acc[0][1]);
      acc[1][0] = MFMA32(fa1, fb0, acc[1][0]);
      acc[1][1] = MFMA32(fa1, fb1, acc[1][1]);
      acc[2][0] = MFMA32(fa2, fb0, acc[2][0]);
      acc[2][1] = MFMA32(fa2, fb1, acc[2][1]);
      acc[3][0] = MFMA32(fa3, fb0, acc[3][0]);
      acc[3][1] = MFMA32(fa3, fb1, acc[3][1]);
    }
  };
  __syncthreads();
  GL256(0);
  SW256();
  __syncthreads();
#pragma unroll 1
  for (int kt = 0; kt < nk - 1; ++kt) {
    GL256(kt + 1);
    __builtin_amdgcn_sched_barrier(0);
    compute();
    __syncthreads();
    SW256();
    __syncthreads();
  }
  compute();
  __syncthreads();
#undef GL256
#undef SW256
}

DI void zero_acc256(f32x16 (&acc)[4][2]) {
#pragma unroll
  for (int a = 0; a < 4; ++a)
#pragma unroll
    for (int b = 0; b < 2; ++b)
#pragma unroll
      for (int i = 0; i < 16; ++i) acc[a][b][i] = 0.f;
}

DI void stage_half(const f32x16 (&acc)[4][2], int hsel, unsigned char* smem) {
  const int tid = otid(), lane = tid & 63, wave = tid >> 6;
  const int wm = wave >> 1, wn = wave & 1, hh = lane >> 5;
  float* Cs = (float*)smem;
  if (wm == hsel) {
#pragma unroll
    for (int mi = 0; mi < 4; ++mi)
#pragma unroll
      for (int ni = 0; ni < 2; ++ni)
#pragma unroll
        for (int i = 0; i < 16; ++i)
          Cs[(mi * 32 + crow(i, hh)) * LDC + wn * 64 + ni * 32 + (lane & 31)] = acc[mi][ni][i];
  }
  __syncthreads();
}

DI void transpose_job(const float* __restrict__ src, bf16_t* __restrict__ dst, int K, int N,
                      const float* __restrict__ sc, int local, float* tile) {
  const int tid = otid();
  const int ntn = N >> 6;
  const int tk = local / ntn, tn = local - tk * ntn;
#pragma unroll
  for (int i = 0; i < 4; ++i) {
    const int idx = tid + 256 * i, r = idx >> 4, c4 = (idx & 15) * 4;
    float4 v = *(const float4*)(src + (size_t)(tk * 64 + r) * N + tn * 64 + c4);
    if (sc) { const float s = sc[tk * 64 + r]; v.x *= s; v.y *= s; v.z *= s; v.w *= s; }
    float* t = tile + r * 65 + c4;
    t[0] = v.x; t[1] = v.y; t[2] = v.z; t[3] = v.w;
  }
  __syncthreads();
#pragma unroll
  for (int i = 0; i < 2; ++i) {
    const int idx = tid + 256 * i, n = idx >> 3, k8 = (idx & 7) * 8;
    const float* t = tile + k8 * 65 + n;
    uint4 o;
    o.x = pack2(t[0 * 65], t[1 * 65]); o.y = pack2(t[2 * 65], t[3 * 65]);
    o.z = pack2(t[4 * 65], t[5 * 65]); o.w = pack2(t[6 * 65], t[7 * 65]);
    *(uint4*)(dst + (size_t)(tn * 64 + n) * K + tk * 64 + k8) = o;
  }
  __syncthreads();
}

constexpr int NT_EARLY = 1376 + 16 + 16;
constexpr int NT_LATE = 1024 + 1024 + 256 + 256 + 64 + 128 + 128 + 16;
DI void transpose_early(const Params& P, int l, float* tile) {
  unsigned char* ws = P.ws;
  if (l < 1376) { transpose_job(P.in[3], (bf16_t*)(ws + OFF_WIN), 1024, 5504, P.in[2], l, tile); return; }
  l -= 1376;
  if (l < 16) { int d = l >> 3; transpose_job(P.in[7] + d * 64 * 512, (bf16_t*)(ws + OFF_W2T) + d * 512 * 64, 64, 512, nullptr, l & 7, tile); return; }
  l -= 16;
  { int d = l >> 3; transpose_job(P.in[9] + d * 64 * 512, (bf16_t*)(ws + OFF_A2T) + d * 512 * 64, 64, 512, nullptr, l & 7, tile); }
}
DI void transpose_late(const Params& P, int l, float* tile) {
  unsigned char* ws = P.ws;
  if (l < 1024) { transpose_job(P.in[25], (bf16_t*)(ws + OFF_W1), 1024, 4096, P.in[24], l, tile); return; }
  l -= 1024;
  if (l < 1024) { transpose_job(P.in[26], (bf16_t*)(ws + OFF_W2F), 4096, 1024, nullptr, l, tile); return; }
  l -= 1024;
  if (l < 256) { transpose_job(P.in[23], (bf16_t*)(ws + OFF_WOUT), 1024, 1024, nullptr, l, tile); return; }
  l -= 256;
  if (l < 256) { transpose_job(P.in[28], (bf16_t*)(ws + OFF_WPG), 1024, 1024, P.in[27], l, tile); return; }
  l -= 256;
  if (l < 64) { transpose_job(P.in[29], (bf16_t*)(ws + OFF_WPP), 256, 1024, nullptr, l, tile); return; }
  l -= 64;
  if (l < 128) { transpose_job(P.in[16], (bf16_t*)(ws + OFF_WOA), 512, 1024, nullptr, l, tile); return; }
  l -= 128;
  if (l < 128) { transpose_job(P.in[22], (bf16_t*)(ws + OFF_WOB), 512, 1024, nullptr, l, tile); return; }
  l -= 128;
  transpose_job(P.in[10], (bf16_t*)(ws + OFF_G2T), 128, 512, nullptr, l, tile);
}

DI void phase_prep(const Params& P, unsigned char* smem) {
  float* tile = (float*)smem;
  unsigned char* ws = P.ws;
  const int tid = otid(), lane = tid & 63, wave = tid >> 6;
  for (int w = blockIdx.x; w < NT_EARLY; w += gridDim.x) transpose_early(P, w, tile);
  float* small = (float*)(ws + OFF_SMALL);
  const float* x = P.in[0];
  for (int row = blockIdx.x * 4 + wave; row < T; row += gridDim.x * 4) {
    float s = 0.f;
#pragma unroll
    for (int i = 0; i < 4; ++i) {
      float4 v = *(const float4*)(x + (size_t)row * DM + (lane + 64 * i) * 4);
      s += v.x * v.x + v.y * v.y + v.z * v.z + v.w * v.w;
      *(uint2*)((bf16_t*)(ws + OFF_H0) + (size_t)row * DM + (lane + 64 * i) * 4) = pack4(v.x, v.y, v.z, v.w);
    }
    s = wave_sum(s);
    if (lane == 0) small[row] = rsqrtf(s * (1.0f / 1024.0f) + 1e-6f);
  }
  for (int i = blockIdx.x * NTHREADS + tid; i < 3 * T + 64; i += gridDim.x * NTHREADS) small[T + i] = 0.f;
}

__device__ __constant__ float c_invf[8] = {1.0f, 0.19392274474868576f, 0.03760603093086393f, 0.007292664737217109f,
                                           0.001414213562373095f, 0.0002742481756762073f, 5.318295896944988e-05f,
                                           1.031338537721246e-05f};

DI void rope_sincos(float ang, float& c, float& s) {
  float n = rintf(ang * 0.15915494309189535f);
  float r = fmaf(-n, 6.2831855f, ang);
  r = fmaf(-n, -1.7484555e-07f, r);
  s = __sinf(r);
  c = __cosf(r);
}

DI void phase_p1(const Params& P, unsigned char* smem) {
  unsigned char* ws = P.ws;
  const int tid = otid();
  const float* x = P.in[0];
  const bf16_t* WinT = (const bf16_t*)(ws + OFF_WIN);
  const float* rstd0 = (const float*)(ws + OFF_SMALL);
  bf16_t* UR = (bf16_t*)P.out;
  bf16_t* Qb = (bf16_t*)(ws + OFF_Q);
  bf16_t* Kb = (bf16_t*)(ws + OFF_K);
  bf16_t* Vt = (bf16_t*)(ws + OFF_VT);
  const float* Cs = (const float*)smem;
  constexpr float QSCALE = 0.18033688011112042f;
  auto epi = [&](int m0, int nt) __attribute__((always_inline)) {
    const int b = m0 >> 13;
    if (nt >= 15 && nt < 23) {
      float* Cw = (float*)smem;
#pragma unroll 2
      for (int it = 0; it < 8; ++it) {
        const int idx = tid + 256 * it;
        const int fi = idx & 7, hl = (idx >> 3) & 1, row = idx >> 4;
        const int pos = (m0 + row) & (SEQ - 1);
        float c, s;
        rope_sincos((float)pos * c_invf[fi], c, s);
        float* p1 = Cw + row * LDC + hl * 64 + fi;
        const float x1 = p1[0], x2 = p1[8];
        p1[0] = x1 * c - x2 * s;
        p1[8] = x2 * c + x1 * s;
      }
      __syncthreads();
    }
    if (nt < 23) {
#pragma unroll 4
      for (int it = 0; it < 16; ++it) {
        int idx = tid + 256 * it, row = idx >> 5, c4 = (idx & 31) * 4;
        int grow = m0 + row;
        float rs = rstd0[grow];
        float4 v = *(const float4*)(Cs + row * LDC + c4);
        v.x *= rs; v.y *= rs; v.z *= rs; v.w *= rs;
        if (nt < 15) {
          *(uint2*)(UR + (size_t)grow * 1920 + nt * 128 + c4) = pack4(v.x, v.y, v.z, v.w);
        } else {
          const bool isq = nt < 19;
          const int hc = (nt - (isq ? 15 : 19)) * 2 + (c4 >> 6);
          const int d = c4 & 63;
          const int pos = grow & (SEQ - 1);
          if (isq) { v.x *= QSCALE; v.y *= QSCALE; v.z *= QSCALE; v.w *= QSCALE; }
          bf16_t* dst = (isq ? Qb : Kb) + ((size_t)(b * 8 + hc) * SEQ + pos) * 64 + d;
          *(uint2*)dst = pack4(v.x, v.y, v.z, v.w);
        }
      }
    } else {
      const int h = nt - 23;
      const int s0 = m0 & (SEQ - 1);
#pragma unroll 2
      for (int it = 0; it < 8; ++it) {
        int idx = tid + 256 * it, dv = idx & 127, rg = idx >> 7;
        float vals[8];
#pragma unroll
        for (int j = 0; j < 8; ++j) vals[j] = Cs[(rg * 8 + j) * LDC + dv] * rstd0[m0 + rg * 8 + j];
        uint4 o;
        o.x = pack2(vals[0], vals[1]); o.y = pack2(vals[2], vals[3]);
        o.z = pack2(vals[4], vals[5]); o.w = pack2(vals[6], vals[7]);
        *(uint4*)(Vt + ((size_t)(b * 4 + h) * 128 + dv) * SEQ + s0 + rg * 8) = o;
      }
    }
  };
#pragma unroll 1
  for (int ta = blockIdx.x; ta < 1536; ta += gridDim.x) {
    const int x = ta & 7, j = ta >> 3, q = j & 63;
    const int nt = (j >> 6) * 8 + (q >> 3), mt = x * 8 + (q & 7);
    const int m0 = mt * 256;
    f32x16 acc[4][2];
    zero_acc256(acc);
    gemm_tile256(acc, (const bf16_t*)(ws + OFF_H0), DM, WinT + (size_t)nt * 128 * DM, DM, DM, m0, smem);
#pragma unroll 1
    for (int hsel = 0; hsel < 2; ++hsel) {
      stage_half(acc, hsel, smem);
      epi(m0 + hsel * 128, nt);
      __syncthreads();
    }
  }
#pragma unroll 1
  for (int tb = blockIdx.x; tb < 384; tb += gridDim.x) {
    const int x = tb & 7, j = tb >> 3;
    const int nt = 24 + (j >> 4), mt = x * 16 + (j & 15);
    const int m0 = mt * 128;
    f32x16 acc[2][2];
    zero_acc(acc);
    gemm_tile<false>(acc, (const bf16_t*)(ws + OFF_H0), DM, WinT + (size_t)nt * 128 * DM, DM, DM, m0, smem);
    stage_acc(acc, smem);
    epi(m0, nt);
  }
}

DI void phase_e1(const Params& P) {
  unsigned char* ws = P.ws;
  const int tid = otid(), lane = tid & 63, wave = tid >> 6;
  const bf16_t* UR = (const bf16_t*)P.out;
  const float* mup = P.in[4];
  const float* mun = P.in[5];
  const float* k_k = P.in[11];
  bf16_t* R = (bf16_t*)(ws + OFF_S);
  bf16_t* V = R + (size_t)T * 512;
  bf16_t* NKK = V + (size_t)T * 512;
  bf16_t* KT = (bf16_t*)(ws + OFF_KTMP);
  bf16_t* AWD = (bf16_t*)(ws + OFF_AWD);
  bf16_t* AAD = (bf16_t*)(ws + OFF_AAD);
  bf16_t* AGD = (bf16_t*)(ws + OFF_AGD);
  const float4 zero4 = make_float4(0.f, 0.f, 0.f, 0.f);
  for (int g = blockIdx.x * 4 + wave; g < T / 8; g += gridDim.x * 4) {
    const int t0 = g * 8;
#pragma unroll
    for (int i = 0; i < 8; ++i) {
      const int c = 4 * lane + 256 * i;
      if (c < 1920) {
        const float4 mp = *(const float4*)(mup + c);
        const float4 mn = *(const float4*)(mun + c);
        float4 kk4 = zero4;
        if (i == 2 || i == 3) kk4 = *(const float4*)(k_k + (c - 512));
        const bf16_t* up_ = UR + (size_t)t0 * 1920 + c;
        float4 prv = ((t0 & (SEQ - 1)) > 0) ? unpack4(*(const uint2*)(up_ - 1920)) : zero4;
        float4 u = unpack4(*(const uint2*)(up_));
#pragma unroll
        for (int tt = 0; tt < 8; ++tt) {
          const int t = t0 + tt;
          const float4 un = ((t & (SEQ - 1)) < SEQ - 1) ? unpack4(*(const uint2*)(up_ + (size_t)(tt + 1) * 1920)) : zero4;
          float4 s;
          s.x = u.x + mp.x * (prv.x - u.x) + mn.x * (un.x - u.x);
          s.y = u.y + mp.y * (prv.y - u.y) + mn.y * (un.y - u.y);
          s.z = u.z + mp.z * (prv.z - u.z) + mn.z * (un.z - u.z);
          s.w = u.w + mp.w * (prv.w - u.w) + mn.w * (un.w - u.w);
          if (i < 2) {
            *(uint2*)(R + (size_t)t * 512 + c) = pack4(s.x, s.y, s.z, s.w);
          } else if (i < 4) {
            const int cc = c - 512;
            float4 q = make_float4(s.x * kk4.x, s.y * kk4.y, s.z * kk4.z, s.w * kk4.w);
            float ss = q.x * q.x + q.y * q.y + q.z * q.z + q.w * q.w;
            ss = row16_sum(ss);
            float inv = -1.0f / fmaxf(sqrtf(ss), 1e-12f);
            *(uint2*)(KT + (size_t)t * 512 + cc) = pack4(s.x, s.y, s.z, s.w);
            *(uint2*)(NKK + (size_t)t * 512 + cc) = pack4(q.x * inv, q.y * inv, q.z * inv, q.w * inv);
          } else if (i < 6) {
            *(uint2*)(V + (size_t)t * 512 + (c - 1024)) = pack4(s.x, s.y, s.z, s.w);
          } else if (c < 1664) {
            float4 o;
            o.x = 1.f - 2.f / (1.f + __expf(2.f * s.x)); o.y = 1.f - 2.f / (1.f + __expf(2.f * s.y));
            o.z = 1.f - 2.f / (1.f + __expf(2.f * s.z)); o.w = 1.f - 2.f / (1.f + __expf(2.f * s.w));
            *(uint2*)(AWD + (size_t)t * 128 + (c - 1536)) = pack4(o.x, o.y, o.z, o.w);
          } else if (c < 1792) {
            *(uint2*)(AAD + (size_t)t * 128 + (c - 1664)) = pack4(s.x, s.y, s.z, s.w);
          } else {
            *(uint2*)(AGD + (size_t)t * 128 + (c - 1792)) =
                pack4(sigmoidf_(s.x), sigmoidf_(s.y), sigmoidf_(s.z), sigmoidf_(s.w));
          }
          prv = u;
          u = un;
        }
      }
    }
  }
}

DI void phase_lora(const Params& P, unsigned char* smem) {
  unsigned char* ws = P.ws;
  const int tid = otid();
  const float* Cs = (const float*)smem;
  bf16_t* Sb = (bf16_t*)(ws + OFF_S);
  const bf16_t* NKK = Sb + 2 * (size_t)T * 512;
  const bf16_t* KT = (const bf16_t*)(ws + OFF_KTMP);
  const float* w0 = P.in[6];
  const float* a0 = P.in[8];
  const float* k_a = P.in[12];
  for (int item = blockIdx.x; item < 128 * 16; item += gridDim.x) {
    const int kind = item & 3, nt = (item >> 2) & 3, mt = item >> 4;
    const int d = kind & 1;
    const bool isdecay = kind < 2;
    const int m0 = mt * 128;
    const bf16_t* A = (const bf16_t*)(ws + (isdecay ? OFF_AWD : OFF_AAD)) + d * 64;
    const bf16_t* Bt = (const bf16_t*)(ws + (isdecay ? OFF_W2T : OFF_A2T)) + (size_t)d * 512 * 64 + (size_t)nt * 128 * 64;
    f32x16 acc[2][2];
    zero_acc(acc);
    gemm_tile<false>(acc, A, 128, Bt, 64, 64, m0, smem);
    stage_acc(acc, smem);
    bf16_t* E = Sb + (size_t)(3 + d) * T * 512;
    bf16_t* KD = Sb + (size_t)(5 + d) * T * 512;
    bf16_t* BB = Sb + (size_t)(7 + d) * T * 512;
#pragma unroll 4
    for (int it = 0; it < 16; ++it) {
      int idx = tid + 256 * it, row = idx >> 5, c4 = (idx & 31) * 4;
      size_t grow = m0 + row;
      int c = nt * 128 + c4;
      float4 v = *(const float4*)(Cs + row * LDC + c4);
      if (isdecay) {
        float4 b4 = *(const float4*)(w0 + d * 512 + c);
        const float E5 = 0.6065306597126334f;
        *(uint2*)(E + grow * 512 + c) = pack4(E5 * sigmoidf_(v.x + b4.x), E5 * sigmoidf_(v.y + b4.y),
                                              E5 * sigmoidf_(v.z + b4.z), E5 * sigmoidf_(v.w + b4.w));
      } else {
        float4 b4 = *(const float4*)(a0 + d * 512 + c);
        float4 ka = *(const float4*)(k_a + c);
        float4 k = unpack4(*(const uint2*)(KT + grow * 512 + c));
        float4 nk = unpack4(*(const uint2*)(NKK + grow * 512 + c));
        float ax = sigmoidf_(v.x + b4.x), ay = sigmoidf_(v.y + b4.y), az = sigmoidf_(v.z + b4.z), aw = sigmoidf_(v.w + b4.w);
        *(uint2*)(KD + grow * 512 + c) = pack4(k.x * (1.f + (ax - 1.f) * ka.x), k.y * (1.f + (ay - 1.f) * ka.y),
                                               k.z * (1.f + (az - 1.f) * ka.z), k.w * (1.f + (aw - 1.f) * ka.w));
        *(uint2*)(BB + grow * 512 + c) = pack4(-nk.x * ax, -nk.y * ay, -nk.z * az, -nk.w * aw);
      }
    }
  }
}

typedef float f2 __attribute__((ext_vector_type(2)));
struct ScanOps { float4 r4, nk, w4, kd, bb; float v; };

template <int DIR>
DI void scan_item(const Params& P, int item, unsigned char* smem) {
  unsigned char* ws = P.ws;
  const int tid = otid(), lane = tid & 63;
  const int wave = __builtin_amdgcn_readfirstlane(tid >> 6);
  const int rg8 = item & 7, h = (item >> 4) & 7, b = item >> 7;
  constexpr int BUFSTRIDE = 5 * 16 * 64 + 16 * 8;
  constexpr int NCH = SEQ / 16;
  float* Xs0 = (float*)smem;
  const bf16_t* Sb = (const bf16_t*)(ws + OFF_S);
  const size_t tokbase = (size_t)b * SEQ;
  if (wave >= 2) {
    const bf16_t* arr0 = Sb;
    const bf16_t* arr1 = Sb + 2 * (size_t)T * 512;
    const bf16_t* arr2 = Sb + (size_t)(3 + DIR) * T * 512;
    const bf16_t* arr3 = Sb + (size_t)(5 + DIR) * T * 512;
    const bf16_t* arr4 = Sb + (size_t)(7 + DIR) * T * 512;
    const bf16_t* Vg = Sb + (size_t)T * 512;
    const int lt = tid - 128;
    const int stp = lt >> 3, part = lt & 7;
    const unsigned loff = (unsigned)(stp * 512 + h * 64 + part * 8);
    const unsigned voff = (unsigned)((lt & 15) * 512 + h * 64 + rg8 * 8);
    uint4 a0, a1, a2, a3, a4, av, b0, b1, b2, b3, b4, bv;
    av = make_uint4(0, 0, 0, 0); bv = av;
#define SCAN_GL(c, r0, r1, r2, r3, r4, rv) { \
      const int tlo_ = DIR ? (SEQ - 16 - 16 * (c)) : 16 * (c); \
      const size_t ub_ = (tokbase + tlo_) * 512; \
      r0 = *(const uint4*)(arr0 + ub_ + loff); r1 = *(const uint4*)(arr1 + ub_ + loff); \
      r2 = *(const uint4*)(arr2 + ub_ + loff); r3 = *(const uint4*)(arr3 + ub_ + loff); \
      r4 = *(const uint4*)(arr4 + ub_ + loff); \
      if (lt < 16) rv = *(const uint4*)(Vg + ub_ + voff); }
    auto st8 = [&](float* dst, uint4 v, bool isw) __attribute__((always_inline)) {
      float f0 = bf2f(v.x & 0xffffu), f1 = bf2f(v.x >> 16), f2_ = bf2f(v.y & 0xffffu), f3 = bf2f(v.y >> 16);
      float f4 = bf2f(v.z & 0xffffu), f5 = bf2f(v.z >> 16), f6 = bf2f(v.w & 0xffffu), f7 = bf2f(v.w >> 16);
      if (isw) {
        f0 = __expf(-f0); f1 = __expf(-f1); f2_ = __expf(-f2_); f3 = __expf(-f3);
        f4 = __expf(-f4); f5 = __expf(-f5); f6 = __expf(-f6); f7 = __expf(-f7);
      }
      *(float4*)(dst) = make_float4(f0, f1, f2_, f3);
      *(float4*)(dst + 4) = make_float4(f4, f5, f6, f7);
    };
#define SCAN_SW(c, r0, r1, r2, r3, r4, rv) { \
      float* X_ = Xs0 + ((c) & 1) * BUFSTRIDE; \
      st8(X_ + (0 * 16 + stp) * 64 + part * 8, r0, false); st8(X_ + (1 * 16 + stp) * 64 + part * 8, r1, false); \
      st8(X_ + (2 * 16 + stp) * 64 + part * 8, r2, true);  st8(X_ + (3 * 16 + stp) * 64 + part * 8, r3, false); \
      st8(X_ + (4 * 16 + stp) * 64 + part * 8, r4, false); \
      if (lt < 16) st8(X_ + 5120 + lt * 8, rv, false); }
    SCAN_GL(0, a0, a1, a2, a3, a4, av);
    SCAN_GL(1, b0, b1, b2, b3, b4, bv);
    SCAN_SW(0, a0, a1, a2, a3, a4, av);
    SCAN_GL(2, a0, a1, a2, a3, a4, av);
    __syncthreads();
#pragma unroll 1
    for (int c = 0; c < NCH; c += 2) {
      if (c + 1 < NCH) SCAN_SW(c + 1, b0, b1, b2, b3, b4, bv);
      if (c + 3 < NCH) SCAN_GL(c + 3, b0, b1, b2, b3, b4, bv);
      __syncthreads();
      if (c + 2 < NCH) SCAN_SW(c + 2, a0, a1, a2, a3, a4, av);
      if (c + 4 < NCH) SCAN_GL(c + 4, a0, a1, a2, a3, a4, av);
      __syncthreads();
    }
#undef SCAN_GL
#undef SCAN_SW
  } else {
    const int cg = lane & 15, rowq = lane >> 4;
    const int rowl = wave * 4 + rowq;
    const int row = rg8 * 8 + rowl;
    bf16_t* Y = (bf16_t*)P.out + (size_t)DIR * T * 512;
    f2 S01 = {0.f, 0.f}, S23 = {0.f, 0.f};
    float ysel = 0.f;
    float4 rprev = make_float4(0.f, 0.f, 0.f, 0.f);
    __syncthreads();
#pragma unroll 1
    for (int c = 0; c < NCH; ++c) {
      const float* xbase = Xs0 + (c & 1) * BUFSTRIDE + cg * 4;
      const float* vbase = Xs0 + (c & 1) * BUFSTRIDE + 5120 + rowl;
      auto ld = [&](ScanOps& o, int j) __attribute__((always_inline)) {
        const int jj = DIR ? 15 - j : j;
        const float* xs = xbase + jj * 64;
        o.r4 = *(const float4*)(xs);
        o.nk = *(const float4*)(xs + 1024);
        o.w4 = *(const float4*)(xs + 2048);
        o.kd = *(const float4*)(xs + 3072);
        o.bb = *(const float4*)(xs + 4096);
        o.v = vbase[jj * 8];
      };
      ScanOps q0, q1, q2;
      ld(q0, 0);
      ld(q1, 1);
#pragma unroll
      for (int j = 0; j < 16; ++j) {
        if (j + 2 < 16) ld(q2, j + 2);
        const ScanOps& cur = q0;
        f2 t = S01 * (f2){cur.nk.x, cur.nk.y};
        t = S23 * (f2){cur.nk.z, cur.nk.w} + t;
        f2 qy = S01 * (f2){rprev.x, rprev.y};
        qy = S23 * (f2){rprev.z, rprev.w} + qy;
        float p = t.x + t.y;
        float y = qy.x + qy.y;
        f2 vv = {cur.v, cur.v};
        f2 u01 = vv * (f2){cur.kd.x, cur.kd.y};
        f2 u23 = vv * (f2){cur.kd.z, cur.kd.w};
        p = dpp_add<0x128>(p); y = dpp_add<0x128>(y);
        p = dpp_add<0x124>(p); y = dpp_add<0x124>(y);
        p = dpp_add<0x122>(p); y = dpp_add<0x122>(y);
        p = dpp_add<0x121>(p); y = dpp_add<0x121>(y);
        f2 pp = {p, p};
        u01 = pp * (f2){cur.bb.x, cur.bb.y} + u01;
        u23 = pp * (f2){cur.bb.z, cur.bb.w} + u23;
        S01 = S01 * (f2){cur.w4.x, cur.w4.y} + u01;
        S23 = S23 * (f2){cur.w4.z, cur.w4.w} + u23;
        if (j == 0) {
          ysel = (cg == 15) ? y : ysel;
          if (c > 0) {
            const int n = (c - 1) * 16 + cg;
            const int t_ = DIR ? (SEQ - 1 - n) : n;
            Y[(tokbase + t_) * 512 + h * 64 + row] = (bf16_t)(pack2(ysel, 0.f) & 0xffffu);
          }
        } else {
          ysel = (cg == j - 1) ? y : ysel;
        }
        rprev = cur.r4;
        q0 = q1;
        q1 = q2;
      }
      __syncthreads();
    }
    {
      f2 qy = S01 * (f2){rprev.x, rprev.y};
      qy = S23 * (f2){rprev.z, rprev.w} + qy;
      float y = qy.x + qy.y;
      y = row16_sum(y);
      ysel = (cg == 15) ? y : ysel;
      const int n = (NCH - 1) * 16 + cg;
      const int t_ = DIR ? (SEQ - 1 - n) : n;
      Y[(tokbase + t_) * 512 + h * 64 + row] = (bf16_t)(pack2(ysel, 0.f) & 0xffffu);
    }
  }
}

constexpr int KLD = 72;
constexpr int VLD = 68;

DI void attn_item(const Params& P, int item, unsigned char* smem, float lam) {
  unsigned char* ws = P.ws;
  const int tid = otid(), lane = tid & 63, wave = tid >> 6;
  const int hh = lane >> 5;
  const int qb = item & 63, h = (item >> 6) & 3, b = item >> 8;
  const int q0 = qb * 128 + wave * 32;
  bf16_t* Ks = (bf16_t*)smem;
  bf16_t* Vs = Ks + 2 * 64 * KLD;
  const bf16_t* Qg = (const bf16_t*)(ws + OFF_Q);
  const bf16_t* Kg = (const bf16_t*)(ws + OFF_K);
  const bf16_t* Vp = (const bf16_t*)(ws + OFF_VT) + (size_t)(b * 4 + h) * 128 * SEQ;
  const float* subln = P.in[21];
  bf16_t* YB = (bf16_t*)(ws + OFF_YB);
#pragma unroll 1
  for (int ci = 0; ci < 2; ++ci) {
    const int hc = h * 2 + (1 - ci);
    const bf16_t* Qp = Qg + ((size_t)(b * 8 + hc) * SEQ + q0 + (lane & 31)) * 64 + hh * 8;
    bf16x8 qf[4];
#pragma unroll
    for (int ks = 0; ks < 4; ++ks) qf[ks] = *(const bf16x8*)(Qp + ks * 16);
    const bf16_t* Kp = Kg + (size_t)(b * 8 + hc) * SEQ * 64;
    f32x16 o[4];
#pragma unroll
    for (int mt = 0; mt < 4; ++mt)
#pragma unroll
      for (int i = 0; i < 16; ++i) o[mt][i] = 0.f;
    float m_run = 0.f, l_run = 0.f;
    uint4 kr0, kr1, vr0, vr1, vr2, vr3;
    const unsigned koff32 = (unsigned)((tid >> 3) * 64 + (tid & 7) * 8);
    const unsigned voff32 = (unsigned)((tid >> 3) * SEQ + (tid & 7) * 8);
    auto glk = [&](int kt) __attribute__((always_inline)) {
      const bf16_t* kb_ = Kp + kt * 4096;
      kr0 = *(const uint4*)(kb_ + koff32);
      kr1 = *(const uint4*)((kb_ + 2048) + koff32);
    };
    auto glv = [&](int kt) __attribute__((always_inline)) {
      const bf16_t* vb_ = Vp + kt * 64;
      vr0 = *(const uint4*)(vb_ + voff32);
      vr1 = *(const uint4*)((vb_ + 32 * SEQ) + voff32);
      vr2 = *(const uint4*)((vb_ + 64 * SEQ) + voff32);
      vr3 = *(const uint4*)((vb_ + 96 * SEQ) + voff32);
    };
    const int sw_r = tid >> 3, sw_p = (tid & 7) * 8;
    auto swv = [&](bf16_t* dst, uint4 v) __attribute__((always_inline)) {
      *(uint2*)(dst) = make_uint2(v.x, v.y);
      *(uint2*)(dst + 4) = make_uint2(v.z, v.w);
    };
    auto sw = [&](int buf) __attribute__((always_inline)) {
      bf16_t* kd = Ks + buf * 64 * KLD + sw_r * KLD + sw_p;
      *(uint4*)(kd) = kr0;
      *(uint4*)(kd + 32 * KLD) = kr1;
      bf16_t* vd = Vs + buf * 128 * VLD + sw_r * VLD + sw_p;
      swv(vd, vr0);
      swv(vd + 32 * VLD, vr1);
      swv(vd + 64 * VLD, vr2);
      swv(vd + 96 * VLD, vr3);
    };
    __syncthreads();
    glk(0);
    glv(0);
    sw(0);
    __syncthreads();
#pragma unroll 1
    for (int kt = 0; kt < 128; ++kt) {
      const int buf = kt & 1;
      const bf16_t* kb = Ks + buf * 64 * KLD + (lane & 31) * KLD + hh * 8;
      const bf16x8 ka0 = *(const bf16x8*)(kb + 0), ka1 = *(const bf16x8*)(kb + 16);
      const bf16x8 ka2 = *(const bf16x8*)(kb + 32), ka3 = *(const bf16x8*)(kb + 48);
      if (kt + 1 < 128) glk(kt + 1);
      __builtin_amdgcn_sched_barrier(0);
      f32x16 st0, st1;
      const bf16x8 kc0 = *(const bf16x8*)(kb + 32 * KLD + 0), kc1 = *(const bf16x8*)(kb + 32 * KLD + 16);
      const bf16x8 kc2 = *(const bf16x8*)(kb + 32 * KLD + 32), kc3 = *(const bf16x8*)(kb + 32 * KLD + 48);
      __builtin_amdgcn_sched_barrier(0);
      if (__any(m_run != 0.f)) {
        const float ninit = -m_run;
#pragma unroll
        for (int i = 0; i < 16; ++i) { st0[i] = ninit; st1[i] = ninit; }
        st0 = MFMA32(ka0, qf[0], st0);
        st0 = MFMA32(ka1, qf[1], st0);
        st0 = MFMA32(ka2, qf[2], st0);
        st0 = MFMA32(ka3, qf[3], st0);
        st1 = MFMA32(kc0, qf[0], st1);
        st1 = MFMA32(kc1, qf[1], st1);
        st1 = MFMA32(kc2, qf[2], st1);
        st1 = MFMA32(kc3, qf[3], st1);
      } else {
        f32x16 z;
#pragma unroll
        for (int i = 0; i < 16; ++i) z[i] = 0.f;
        st0 = MFMA32(ka0, qf[0], z);
        st0 = MFMA32(ka1, qf[1], st0);
        st0 = MFMA32(ka2, qf[2], st0);
        st0 = MFMA32(ka3, qf[3], st0);
        st1 = MFMA32(kc0, qf[0], z);
        st1 = MFMA32(kc1, qf[1], st1);
        st1 = MFMA32(kc2, qf[2], st1);
        st1 = MFMA32(kc3, qf[3], st1);
      }
      const bf16_t* vb = Vs + buf * 128 * VLD + (lane & 31) * VLD + hh * 4;
      s16x4 vl0 = *(const s16x4*)(vb + 0 * 32 * VLD), vh0 = *(const s16x4*)(vb + 0 * 32 * VLD + 8);
      s16x4 vl1 = *(const s16x4*)(vb + 1 * 32 * VLD), vh1 = *(const s16x4*)(vb + 1 * 32 * VLD + 8);
      s16x4 vl2 = *(const s16x4*)(vb + 2 * 32 * VLD), vh2 = *(const s16x4*)(vb + 2 * 32 * VLD + 8);
      s16x4 vl3 = *(const s16x4*)(vb + 3 * 32 * VLD), vh3 = *(const s16x4*)(vb + 3 * 32 * VLD + 8);
      if (kt + 1 < 128) glv(kt + 1);
      __builtin_amdgcn_sched_barrier(0);
      float mx = st0[0];
#pragma unroll
      for (int i = 0; i < 16; ++i) { mx = fmaxf(mx, st0[i]); mx = fmaxf(mx, st1[i]); }
      mx = xor32_max(mx);
      const bool first = (kt == 0);
      if (__any(mx > 40.0f) || (first && __any(mx < -40.0f))) {
        const float delta = first ? mx : fmaxf(mx, 0.f);
        const float alpha = first ? 1.0f : __builtin_amdgcn_exp2f(-delta);
        m_run += delta;
        l_run *= alpha;
#pragma unroll
        for (int i = 0; i < 16; ++i) { st0[i] -= delta; st1[i] -= delta; }
#pragma unroll
        for (int mt = 0; mt < 4; ++mt)
#pragma unroll
          for (int i = 0; i < 16; ++i) o[mt][i] *= alpha;
      }
      float ps = 0.f;
#pragma unroll
      for (int i = 0; i < 16; ++i) {
        st0[i] = __builtin_amdgcn_exp2f(st0[i]);
        st1[i] = __builtin_amdgcn_exp2f(st1[i]);
        ps += st0[i] + st1[i];
      }
      l_run += ps;
#pragma unroll
      for (int k4 = 0; k4 < 4; ++k4) {
        const int sub = k4 & 1;
        u32x4 pu;
        if (k4 < 2) {
          pu[0] = pack2(st0[8 * sub + 0], st0[8 * sub + 1]);
          pu[1] = pack2(st0[8 * sub + 2], st0[8 * sub + 3]);
          pu[2] = pack2(st0[8 * sub + 4], st0[8 * sub + 5]);
          pu[3] = pack2(st0[8 * sub + 6], st0[8 * sub + 7]);
        } else {
          pu[0] = pack2(st1[8 * sub + 0], st1[8 * sub + 1]);
          pu[1] = pack2(st1[8 * sub + 2], st1[8 * sub + 3]);
          pu[2] = pack2(st1[8 * sub + 4], st1[8 * sub + 5]);
          pu[3] = pack2(st1[8 * sub + 6], st1[8 * sub + 7]);
        }
        const bf16x8 pfv = __builtin_bit_cast(bf16x8, pu);
        const bf16x8 vf0 = __builtin_shufflevector(vl0, vh0, 0, 1, 2, 3, 4, 5, 6, 7);
        const bf16x8 vf1 = __builtin_shufflevector(vl1, vh1, 0, 1, 2, 3, 4, 5, 6, 7);
        const bf16x8 vf2 = __builtin_shufflevector(vl2, vh2, 0, 1, 2, 3, 4, 5, 6, 7);
        const bf16x8 vf3 = __builtin_shufflevector(vl3, vh3, 0, 1, 2, 3, 4, 5, 6, 7);
        if (k4 < 3) {
          const bf16_t* vn = vb + (k4 + 1) * 16;
          vl0 = *(const s16x4*)(vn + 0 * 32 * VLD); vh0 = *(const s16x4*)(vn + 0 * 32 * VLD + 8);
          vl1 = *(const s16x4*)(vn + 1 * 32 * VLD); vh1 = *(const s16x4*)(vn + 1 * 32 * VLD + 8);
          vl2 = *(const s16x4*)(vn + 2 * 32 * VLD); vh2 = *(const s16x4*)(vn + 2 * 32 * VLD + 8);
          vl3 = *(const s16x4*)(vn + 3 * 32 * VLD); vh3 = *(const s16x4*)(vn + 3 * 32 * VLD + 8);
        }
        __builtin_amdgcn_sched_barrier(0);
        o[0] = MFMA32(vf0, pfv, o[0]);
        o[1] = MFMA32(vf1, pfv, o[1]);
        o[2] = MFMA32(vf2, pfv, o[2]);
        o[3] = MFMA32(vf3, pfv, o[3]);
      }
      if (kt + 1 < 128) sw(buf ^ 1);
      __syncthreads();
    }
    float l = xor32_sum(l_run);
    float inv = 1.0f / l;
    const size_t tok = (size_t)b * SEQ + q0 + (lane & 31);
    if (ci == 0) {
      const float sc = inv * lam;
#pragma unroll
      for (int mt = 0; mt < 4; ++mt)
#pragma unroll
        for (int g = 0; g < 4; ++g) {
          const int dv = 32 * mt + 8 * g + 4 * hh;
          *(uint2*)(YB + tok * 512 + h * 128 + dv) =
              pack4(o[mt][4 * g + 0] * sc, o[mt][4 * g + 1] * sc, o[mt][4 * g + 2] * sc, o[mt][4 * g + 3] * sc);
        }
    } else {
      float ss = 0.f;
#pragma unroll
      for (int mt = 0; mt < 4; ++mt)
#pragma unroll
        for (int g = 0; g < 4; ++g) {
          const int dv = 32 * mt + 8 * g + 4 * hh;
          float4 sv = unpack4(*(const uint2*)(YB + tok * 512 + h * 128 + dv));
          float d0 = o[mt][4 * g + 0] * inv - sv.x, d1 = o[mt][4 * g + 1] * inv - sv.y;
          float d2 = o[mt][4 * g + 2] * inv - sv.z, d3 = o[mt][4 * g + 3] * inv - sv.w;
          o[mt][4 * g + 0] = d0; o[mt][4 * g + 1] = d1; o[mt][4 * g + 2] = d2; o[mt][4 * g + 3] = d3;
          ss += d0 * d0 + d1 * d1 + d2 * d2 + d3 * d3;
        }
      ss = xor32_sum(ss);
      const float rinv = rsqrtf(ss * (1.0f / 128.0f) + 1e-5f) * 0.8f;
#pragma unroll
      for (int mt = 0; mt < 4; ++mt)
#pragma unroll
        for (int g = 0; g < 4; ++g) {
          const int dv = 32 * mt + 8 * g + 4 * hh;
          float4 sw4 = *(const float4*)(subln + dv);
          *(uint2*)(YB + tok * 512 + h * 128 + dv) =
              pack4(o[mt][4 * g + 0] * rinv * sw4.x, o[mt][4 * g + 1] * rinv * sw4.y,
                    o[mt][4 * g + 2] * rinv * sw4.z, o[mt][4 * g + 3] * rinv * sw4.w);
        }
    }
  }
}

DI void phase_mix(const Params& P, unsigned char* smem, int* s_item, int rep = 0, int mode = 3) {
  const int tid = otid();
  if (mode & 1) {
    const bool remap = (gridDim.x == 512);
    for (int sb = blockIdx.x; sb < 256; sb += gridDim.x) {
      const int j = sb >> 3;
      const int si = remap ? ((((sb & 7) * 4 + (j >> 3)) << 3) | (j & 7)) : sb;
      if ((si >> 3) & 1) scan_item<1>(P, si, smem); else scan_item<0>(P, si, smem);
    }
  }
  if (!(mode & 2)) return;
  float a = 0.f, bsum = 0.f;
  {
    const int lane = tid & 63;
    a = P.in[17][lane] * P.in[18][lane];
    bsum = P.in[19][lane] * P.in[20][lane];
    a = wave_sum(a); bsum = wave_sum(bsum);
  }
  const float lam = __expf(a) - __expf(bsum) + 0.2f;
  int* counters = (int*)(P.ws + OFF_SMALL) + 4 * T + rep * 8;
  const int x0 = (int)(xb_xcc_id() & 7u);
  if (tid == 0) s_item[1] = 0;
  for (;;) {
    __syncthreads();
    if (tid == 0) {
      int item = -1;
      int k = s_item[1];
      while (k < 8) {
        const int q = (x0 + k) & 7;
        const int idx = atomicAdd(counters + q, 1);
        if (idx < 64) { item = q * 64 + idx; break; }
        ++k;
      }
      s_item[1] = k;
      s_item[0] = item;
    }
    __syncthreads();
    const int item = __builtin_amdgcn_readfirstlane(*s_item);
    if (item < 0) break;
    attn_item(P, item, smem, lam);
  }
  if (rep == 0) {
    int* tcount = (int*)(P.ws + OFF_SMALL) + 4 * T + 32;
    const float* x = P.in[0];
    bf16_t* H0b = (bf16_t*)P.out + (size_t)T * DM;
    for (;;) {
      __syncthreads();
      if (tid == 0) s_item[0] = atomicAdd(tcount, 1);
      __syncthreads();
      const int l = __builtin_amdgcn_readfirstlane(s_item[0]);
      if (l >= NT_LATE + 256) break;
      if (l < NT_LATE) {
        transpose_late(P, l, (float*)smem);
      } else {
        const size_t base = (size_t)(l - NT_LATE) * 64 * DM;
#pragma unroll 4
        for (int i = 0; i < 64; ++i) {
          const size_t o = base + (size_t)i * DM + tid * 4;
          float4 v = *(const float4*)(x + o);
          *(uint2*)(H0b + o) = pack4(v.x, v.y, v.z, v.w);
        }
      }
    }
  }
}

DI void phase_post(const Params& P, unsigned char* smem) {
  unsigned char* ws = P.ws;
  const int tid = otid();
  const float* Cs = (const float*)smem;
  const bf16_t* Sb = (const bf16_t*)(ws + OFF_S);
  const bf16_t* R = Sb;
  const bf16_t* V = Sb + (size_t)T * 512;
  const bf16_t* KD0 = Sb + (size_t)5 * T * 512;
  const bf16_t* KD1 = Sb + (size_t)6 * T * 512;
  const bf16_t* Y0 = (const bf16_t*)P.out;
  const bf16_t* Y1 = (const bf16_t*)P.out + (size_t)T * 512;
  const float* ln_w = P.in[14];
  const float* ln_b = P.in[15];
  const float* r_k = P.in[13];
  bf16_t* YA = (bf16_t*)(ws + OFF_YA);
  const bf16_t* AGD = (const bf16_t*)(ws + OFF_AGD);
  const bf16_t* G2T = (const bf16_t*)(ws + OFF_G2T);
  for (int item = blockIdx.x; item < 128 * 4; item += gridDim.x) {
    const int nt = item & 3, mt = item >> 2;
    const int m0 = mt * 128;
    f32x16 acc[2][2];
    zero_acc(acc);
    gemm_tile<false>(acc, AGD, 128, G2T + (size_t)nt * 128 * 128, 128, 128, m0, smem);
    stage_acc(acc, smem);
    const int gidx = tid >> 4, l16 = tid & 15;
#pragma unroll 2
    for (int it = 0; it < 16; ++it) {
      const int pair = gidx + 16 * it;
      const int row = pair >> 1, hsel = pair & 1;
      const int cl = hsel * 64 + l16 * 4;
      const int c = nt * 128 + cl;
      const size_t off = (size_t)(m0 + row) * 512 + c;
      float4 y0 = unpack4(*(const uint2*)(Y0 + off));
      float4 y1 = unpack4(*(const uint2*)(Y1 + off));
      float4 y = make_float4(y0.x + y1.x, y0.y + y1.y, y0.z + y1.z, y0.w + y1.w);
      float sm = y.x + y.y + y.z + y.w;
      sm = row16_sum(sm);
      const float mean = sm * (1.0f / 64.0f);
      y.x -= mean; y.y -= mean; y.z -= mean; y.w -= mean;
      float vs = y.x * y.x + y.y * y.y + y.z * y.z + y.w * y.w;
      vs = row16_sum(vs);
      const float rstd = rsqrtf(vs * (1.0f / 64.0f) + 64e-5f);
      float4 lw = *(const float4*)(ln_w + c);
      float4 lb = *(const float4*)(ln_b + c);
      float4 r = unpack4(*(const uint2*)(R + off));
      float4 k0 = unpack4(*(const uint2*)(KD0 + off));
      float4 k1 = unpack4(*(const uint2*)(KD1 + off));
      float4 v = unpack4(*(const uint2*)(V + off));
      float4 rk = *(const float4*)(r_k + c);
      float dt = r.x * (k0.x + k1.x) * rk.x + r.y * (k0.y + k1.y) * rk.y + r.z * (k0.z + k1.z) * rk.z + r.w * (k0.w + k1.w) * rk.w;
      dt = row16_sum(dt);
      float4 g = *(const float4*)(Cs + row * LDC + cl);
      float ox = (y.x * rstd * lw.x + lb.x + dt * v.x) * g.x;
      float oy = (y.y * rstd * lw.y + lb.y + dt * v.y) * g.y;
      float oz = (y.z * rstd * lw.z + lb.z + dt * v.z) * g.z;
      float ow = (y.w * rstd * lw.w + lb.w + dt * v.w) * g.w;
      *(uint2*)(YA + off) = pack4(ox, oy, oz, ow);
    }
  }
}

template <int HALF>
DI void wo_half(const Params& P, unsigned char* smem, float* rs_tile) {
  unsigned char* ws = P.ws;
  const int tid = otid(), lane = tid & 63, wave = tid >> 6;
  const float* Cs = (const float*)smem;
  const float* rstd0 = (const float*)(ws + OFF_SMALL);
  bf16_t* MG = (bf16_t*)(ws + OFF_MERGED);
  bf16_t* PART = (bf16_t*)(ws + OFF_HFF);
  const bf16_t* H0 = (const bf16_t*)P.out + (size_t)T * DM;
  const bf16_t* WinT = (const bf16_t*)(ws + OFF_WIN);
  const bf16_t* Yin = (const bf16_t*)(ws + (HALF ? OFF_YB : OFF_YA));
  const bf16_t* Wo = (const bf16_t*)(ws + (HALF ? OFF_WOB : OFF_WOA));
  const bool xmap = (gridDim.x == 512);
#pragma unroll 1
  for (int tile = blockIdx.x; tile < 128 * 8; tile += gridDim.x) {
    int nt = tile & 7, mt = tile >> 3;
    if (xmap) { const int x = tile & 7, j = tile >> 3, q = j & 63; nt = q >> 3; mt = x * 16 + (j >> 6) * 8 + (q & 7); }
    const int m0 = mt * 128, n0 = nt * 128;
    unsigned gp[2][2][8];
    {
      f32x16 accg[2][2];
      zero_acc(accg);
      gemm_tile<false, 0, false>(accg, H0, DM, WinT + (size_t)((HALF ? 4480 : 3456) + n0) * DM, DM, DM, m0, smem);
      const int wm = wave >> 1, hh = lane >> 5;
      if (tid < 128) rs_tile[tid] = rstd0[m0 + tid];
      __syncthreads();
      const float* rsp = rs_tile + wm * 64 + 4 * hh;
#pragma unroll
      for (int mi = 0; mi < 2; ++mi)
#pragma unroll
        for (int ni = 0; ni < 2; ++ni)
#pragma unroll
          for (int i = 0; i < 16; i += 2) {
            const float rs0 = rsp[mi * 32 + (i & 3) + 8 * (i >> 2)];
            const float rs1 = rsp[mi * 32 + ((i + 1) & 3) + 8 * ((i + 1) >> 2)];
            gp[mi][ni][i >> 1] = pack2(sigmoidf_(rs0 * accg[mi][ni][i]), sigmoidf_(rs1 * accg[mi][ni][i + 1]));
          }
    }
    f32x16 accv[2][2];
    zero_acc(accv);
    gemm_tile<false, 0, false>(accv, Yin, 512, Wo + (size_t)n0 * 512, 512, 512, m0, smem);
#pragma unroll
    for (int mi = 0; mi < 2; ++mi)
#pragma unroll
      for (int ni = 0; ni < 2; ++ni)
#pragma unroll
        for (int i = 0; i < 16; i += 2) {
          const unsigned g = gp[mi][ni][i >> 1];
          accv[mi][ni][i] *= bf2f(g & 0xffffu);
          accv[mi][ni][i + 1] *= bf2f(g >> 16);
        }
    stage_acc(accv, smem);
#pragma unroll 2
    for (int it = 0; it < 16; ++it) {
      int idx = tid + 256 * it, row = idx >> 5, c4 = (idx & 31) * 4;
      const size_t off = (size_t)(m0 + row) * DM + n0 + c4;
      float4 c = *(const float4*)(Cs + row * LDC + c4);
      if (HALF == 0) {
        *(uint2*)(PART + off) = pack4(c.x, c.y, c.z, c.w);
      } else {
        float4 a = unpack4(*(const uint2*)(PART + off));
        *(uint2*)(MG + off) = pack4(a.x + c.x, a.y + c.y, a.z + c.z, a.w + c.w);
      }
    }
  }
}
DI void phase_wo(const Params& P, unsigned char* smem, float* rs_tile) {
  wo_half<0>(P, smem, rs_tile);
  wo_half<1>(P, smem, rs_tile);
}

DI void resid_epilogue(const float* Cs, const float* xi, float* xo, bf16_t* xb, float* ss, int m0, int n0, bool write_xb, const float* mul = nullptr) {
  const int tid = otid();
#pragma unroll 4
  for (int it = 0; it < 16; ++it) {
    int idx = tid + 256 * it, row = idx >> 5, c4 = (idx & 31) * 4;
    size_t off = (size_t)(m0 + row) * DM + n0 + c4;
    float4 a = *(const float4*)(xi + off);
    float4 c = *(const float4*)(Cs + row * LDC + c4);
    if (mul) { float4 g = *(const float4*)(mul + off); c.x *= g.x; c.y *= g.y; c.z *= g.z; c.w *= g.w; }
    float4 o = make_float4(a.x + c.x, a.y + c.y, a.z + c.z, a.w + c.w);
    *(float4*)(xo + off) = o;
    if (write_xb) *(uint2*)(xb + off) = pack4(o.x, o.y, o.z, o.w);
    float s = o.x * o.x + o.y * o.y + o.z * o.z + o.w * o.w;
    s = half32_sum(s);
    if ((tid & 31) == 0) atomicAdd(ss + m0 + row, s);
  }
}

DI void phase_wout(const Params& P, unsigned char* smem) {
  unsigned char* ws = P.ws;
  const float* Cs = (const float*)smem;
  float* small = (float*)(ws + OFF_SMALL);
  const bf16_t* MG = (const bf16_t*)(ws + OFF_MERGED);
  const bf16_t* WoutT = (const bf16_t*)(ws + OFF_WOUT);
  const bool xmap = (gridDim.x == 512);
#pragma unroll 1
  for (int tile = blockIdx.x; tile < 64 * 8; tile += gridDim.x) {
    int nt = tile & 7, mt = tile >> 3;
    if (xmap) { const int x = tile & 7, j = tile >> 3; nt = j >> 3; mt = x * 8 + (j & 7); }
    const int m0 = mt * 256, n0 = nt * 128;
    f32x16 acc[4][2];
    zero_acc256(acc);
    gemm_tile256(acc, MG, DM, WoutT + (size_t)n0 * DM, DM, DM, m0, smem);
#pragma unroll 1
    for (int hsel = 0; hsel < 2; ++hsel) {
      stage_half(acc, hsel, smem);
      resid_epilogue(Cs, P.in[0], P.out, (bf16_t*)(ws + OFF_XB), small + T, m0 + hsel * 128, n0, true);
      __syncthreads();
    }
  }
}

DI void phase_ff1(const Params& P, unsigned char* smem) {
  unsigned char* ws = P.ws;
  const int tid = otid();
  const float* Cs = (const float*)smem;
  const float* ss1 = (const float*)(ws + OFF_SMALL) + T;
  const bf16_t* XB = (const bf16_t*)(ws + OFF_XB);
  const bf16_t* W1T = (const bf16_t*)(ws + OFF_W1);
  bf16_t* HFF = (bf16_t*)(ws + OFF_HFF);
  const bool xmap = (gridDim.x == 512);
#pragma unroll 1
  for (int tile = blockIdx.x; tile < 64 * 32; tile += gridDim.x) {
    int nt = tile & 31, mt = tile >> 5;
    if (xmap) { const int x = tile & 7, j = tile >> 3, q = j & 63; nt = (j >> 6) * 8 + (q >> 3); mt = x * 8 + (q & 7); }
    const int m0 = mt * 256, n0 = nt * 128;
    f32x16 acc[4][2];
    zero_acc256(acc);
    gemm_tile256(acc, XB, DM, W1T + (size_t)n0 * DM, DM, DM, m0, smem);
#pragma unroll 1
    for (int hsel = 0; hsel < 2; ++hsel) {
      stage_half(acc, hsel, smem);
      const int mh = m0 + hsel * 128;
#pragma unroll 4
      for (int it = 0; it < 16; ++it) {
        int idx = tid + 256 * it, row = idx >> 5, c4 = (idx & 31) * 4;
        float rs = rsqrtf(ss1[mh + row] * (1.0f / 1024.0f) + 1e-6f);
        float4 c = *(const float4*)(Cs + row * LDC + c4);
        float hx = fmaxf(c.x * rs, 0.f), hy = fmaxf(c.y * rs, 0.f), hz = fmaxf(c.z * rs, 0.f), hw = fmaxf(c.w * rs, 0.f);
        *(uint2*)(HFF + (size_t)(mh + row) * 4096 + n0 + c4) = pack4(hx * hx, hy * hy, hz * hz, hw * hw);
      }
      __syncthreads();
    }
  }
}

DI void phase_ff2(const Params& P, unsigned char* smem) {
  unsigned char* ws = P.ws;
  const float* Cs = (const float*)smem;
  float* small = (float*)(ws + OFF_SMALL);
  const bf16_t* HFF = (const bf16_t*)(ws + OFF_HFF);
  const bf16_t* W2T = (const bf16_t*)(ws + OFF_W2F);
  const bool xmap = (gridDim.x == 512);
#pragma unroll 1
  for (int tile = blockIdx.x; tile < 64 * 8; tile += gridDim.x) {
    int nt = tile & 7, mt = tile >> 3;
    if (xmap) { const int x = tile & 7, j = tile >> 3; nt = j >> 3; mt = x * 8 + (j & 7); }
    const int m0 = mt * 256, n0 = nt * 128;
    f32x16 acc[4][2];
    zero_acc256(acc);
    gemm_tile256(acc, HFF, 4096, W2T + (size_t)n0 * 4096, 4096, 4096, m0, smem);
#pragma unroll 1
    for (int hsel = 0; hsel < 2; ++hsel) {
      stage_half(acc, hsel, smem);
      resid_epilogue(Cs, P.out, P.out, (bf16_t*)(ws + OFF_XB), small + 2 * T, m0 + hsel * 128, n0, true);
      __syncthreads();
    }
  }
}

DI void phase_ple(const Params& P, unsigned char* smem, float* rs_tile) {
  unsigned char* ws = P.ws;
  const int tid = otid(), lane = tid & 63, wave = tid >> 6;
  const float* Cs = (const float*)smem;
  float* small = (float*)(ws + OFF_SMALL);
  const bf16_t* XB = (const bf16_t*)(ws + OFF_XB);
  const bf16_t* WpgT = (const bf16_t*)(ws + OFF_WPG);
  const bf16_t* WppT = (const bf16_t*)(ws + OFF_WPP);
  const float* ss2 = small + 2 * T;
  const bool xmap = (gridDim.x == 512);
#pragma unroll 1
  for (int tile = blockIdx.x; tile < 128 * 8; tile += gridDim.x) {
    int nt = tile & 7, mt = tile >> 3;
    if (xmap) { const int x = tile & 7, j = tile >> 3, q = j & 63; nt = q >> 3; mt = x * 16 + (j >> 6) * 8 + (q & 7); }
    const int m0 = mt * 128, n0 = nt * 128;
    unsigned gp[2][2][8];
    {
      f32x16 accg[2][2];
      zero_acc(accg);
      gemm_tile<false, 0, false>(accg, XB, DM, WpgT + (size_t)n0 * DM, DM, DM, m0, smem);
      const int wm = wave >> 1, hh = lane >> 5;
      if (tid < 128) rs_tile[tid] = rsqrtf(ss2[m0 + tid] * (1.0f / 1024.0f) + 1e-6f);
      __syncthreads();
      const float* rsp = rs_tile + wm * 64 + 4 * hh;
#pragma unroll
      for (int mi = 0; mi < 2; ++mi)
#pragma unroll
        for (int ni = 0; ni < 2; ++ni)
#pragma unroll
          for (int i = 0; i < 16; i += 2) {
            const float rs0 = rsp[mi * 32 + (i & 3) + 8 * (i >> 2)];
            const float rs1 = rsp[mi * 32 + ((i + 1) & 3) + 8 * ((i + 1) >> 2)];
            gp[mi][ni][i >> 1] = pack2(sigmoidf_(rs0 * accg[mi][ni][i]), sigmoidf_(rs1 * accg[mi][ni][i + 1]));
          }
    }
    f32x16 accv[2][2];
    zero_acc(accv);
    gemm_tile<true>(accv, P.in[1], 256, WppT + (size_t)n0 * 256, 256, 256, m0, smem);
#pragma unroll
    for (int mi = 0; mi < 2; ++mi)
#pragma unroll
      for (int ni = 0; ni < 2; ++ni)
#pragma unroll
        for (int i = 0; i < 16; i += 2) {
          const unsigned g = gp[mi][ni][i >> 1];
          accv[mi][ni][i] *= bf2f(g & 0xffffu);
          accv[mi][ni][i + 1] *= bf2f(g >> 16);
        }
    stage_acc(accv, smem);
    resid_epilogue(Cs, P.out, P.out, nullptr, small + 3 * T, m0, n0, false);
  }
}

DI void phase_final(const Params& P) {
  const float* ss3 = (const float*)(P.ws + OFF_SMALL) + 3 * T;
  const float* g = P.in[30];
  const size_t n4 = (size_t)T * DM / 4;
  for (size_t i = (size_t)blockIdx.x * NTHREADS + threadIdx.x; i < n4; i += (size_t)gridDim.x * NTHREADS) {
    const int row = (int)(i >> 8);
    const int c = (int)(i & 255) * 4;
    const float rs = rsqrtf(ss3[row] * (1.0f / 1024.0f) + 1e-6f);
    float4 v = *(const float4*)(P.out + i * 4);
    float4 gg = *(const float4*)(g + c);
    v.x *= rs * gg.x; v.y *= rs * gg.y; v.z *= rs * gg.z; v.w *= rs * gg.w;
    *(float4*)(P.out + i * 4) = v;
  }
}

#define XB_TMO      128
#define XB_XCNT(j)  (256  + 64 * (j))
#define XB_XSUB(j)  (1280 + 64 * (j))
#define XB_XGEN(j)  (2304 + 64 * (j))
#define XB_TOP      3328
#define XB_TOPGEN   3392
#define XCD_BAR_WORDS 3456
#define XB_SPIN_CAP (1u << 20)
#define LAS __attribute__((address_space(3)))
constexpr size_t OFF_BAR = OFF_SMALL + 524288;

DI unsigned xb_ld(unsigned* p) { return __hip_atomic_load(p, __ATOMIC_RELAXED, __HIP_MEMORY_SCOPE_AGENT); }
DI unsigned xb_add(unsigned* p, unsigned v) { return __hip_atomic_fetch_add(p, v, __ATOMIC_RELAXED, __HIP_MEMORY_SCOPE_AGENT); }
DI unsigned xb_xcc_id() { return (unsigned)__builtin_amdgcn_s_getreg((3 << 11) | 20) & 0xFu; }
#define XB_SPIN(cond, bar) do { unsigned _sp = 0; while (cond) { __builtin_amdgcn_s_sleep(1); \
    if ((++_sp & 255u) == 0u) { if (xb_ld(&(bar)[XB_TMO])) break; if (_sp > XB_SPIN_CAP) { atomicAdd(&(bar)[XB_TMO], 1u); break; } } } } while (0)

struct XcdBarrier { unsigned* bar; unsigned x; volatile unsigned* st; };

DI XcdBarrier xcd_barrier_post(unsigned* bar, volatile unsigned* st) {
  XcdBarrier b; b.bar = bar; b.x = xb_xcc_id(); b.st = st;
  if (threadIdx.x == 0) (void)xb_add(&bar[XB_XCNT(b.x)], 1u);
  return b;
}
DI void xcd_barrier_complete(unsigned* bar, unsigned x, unsigned& nloc, unsigned& nx) {
  const unsigned G = gridDim.x * gridDim.y * gridDim.z;
  unsigned sum, cnt, mine, sp = 0u;
  for (;;) {
    sum = 0u; cnt = 0u; mine = 0u;
#pragma unroll
    for (unsigned j = 0; j < 16; ++j) { const unsigned c = xb_ld(&bar[XB_XCNT(j)]); sum += c; cnt += (c > 0u) ? 1u : 0u; mine = (j == x) ? c : mine; }
    if (sum == G) break;
    __builtin_amdgcn_s_sleep(1);
    if ((++sp & 255u) == 0u) { if (xb_ld(&bar[XB_TMO])) break; if (sp > XB_SPIN_CAP) { atomicAdd(&bar[XB_TMO], 1u); break; } }
  }
  nloc = mine > 0u ? mine : 1u; nx = cnt > 0u ? cnt : 1u;
}
DI void xcd_barrier(const XcdBarrier& b) {
  asm volatile("s_waitcnt vmcnt(0)" ::: "memory");
  __syncthreads();
  if (threadIdx.x == 0) {
    unsigned* bar = b.bar;
    __builtin_amdgcn_s_waitcnt(0);
    unsigned nloc = b.st[0], nx = b.st[1];
    if (nloc == 0u) { xcd_barrier_complete(bar, b.x, nloc, nx); b.st[0] = nloc; b.st[1] = nx; }
    const unsigned old = xb_add(&bar[XB_XSUB(b.x)], 1u);
    const unsigned gen = old / nloc;
    if (old + 1u == (gen + 1u) * nloc) {
      __builtin_amdgcn_fence(__ATOMIC_RELEASE, "agent");
      asm volatile("s_waitcnt vmcnt(0)" ::: "memory");
      const unsigned og = xb_add(&bar[XB_TOP], 1u);
      const unsigned tg = og / nx;
      if (og + 1u == (tg + 1u) * nx) xb_add(&bar[XB_TOPGEN], 1u);
      else XB_SPIN(xb_ld(&bar[XB_TOPGEN]) == tg, bar);
      __builtin_amdgcn_fence(__ATOMIC_ACQUIRE, "agent");
      xb_add(&bar[XB_XGEN(b.x)], 1u);
      asm volatile("s_waitcnt vmcnt(0)" ::: "memory");
    } else {
      XB_SPIN(xb_ld(&bar[XB_XGEN(b.x)]) == gen, bar);
      __builtin_amdgcn_fence(__ATOMIC_ACQUIRE, "agent");
      asm volatile("s_waitcnt vmcnt(0)" ::: "memory");
    }
  }
  __syncthreads();
}

__global__ void __launch_bounds__(NTHREADS, 2) fwd_megakernel(Params P) {
  __shared__ __attribute__((aligned(16))) unsigned char smem[SMEM_BYTES];
  __shared__ int s_item[2];
  __shared__ float rs_tile[128];
  __shared__ uint4 xb_words;
  cg::grid_group grid = cg::this_grid();
  if (P.ws == nullptr) grid.sync();
  if (threadIdx.x == 0) xb_words = make_uint4(0u, 0u, 0u, 0u);
  __syncthreads();
  const XcdBarrier xb = xcd_barrier_post((unsigned*)(P.ws + OFF_BAR), (volatile unsigned*)&xb_words);
  phase_prep(P, smem);
  xcd_barrier(xb);
  phase_p1(P, smem);
  xcd_barrier(xb);
  phase_e1(P);
  xcd_barrier(xb);
  phase_lora(P, smem);
  xcd_barrier(xb);
  phase_mix(P, smem, s_item);
  xcd_barrier(xb);
  phase_post(P, smem);
  xcd_barrier(xb);
  phase_wo(P, smem, rs_tile);
  xcd_barrier(xb);
  phase_wout(P, smem);
  xcd_barrier(xb);
  phase_ff1(P, smem);
  xcd_barrier(xb);
  phase_ff2(P, smem);
  xcd_barrier(xb);
  phase_ple(P, smem, rs_tile);
  xcd_barrier(xb);
  phase_final(P);
}

extern "C" void kernel_launch(void* const* d_in, const int* in_sizes, int n_in, void* d_out, int out_size,
                              void* d_ws, size_t ws_size, hipStream_t stream) {
  static int grid_blocks = 0;
  if (!grid_blocks) {
    int dev = 0, cus = 0, per_cu = 0;
    hipGetDevice(&dev);
    hipDeviceGetAttribute(&cus, hipDeviceAttributeMultiprocessorCount, dev);
    hipOccupancyMaxActiveBlocksPerMultiprocessor(&per_cu, fwd_megakernel, NTHREADS, 0);
    if (per_cu > 2) per_cu = 2;
    if (per_cu < 1) per_cu = 1;
    grid_blocks = cus * per_cu;
  }
  Params p{};
  for (int i = 0; i < 31; ++i) p.in[i] = (const float*)d_in[i];
  p.out = (float*)d_out;
  p.ws = (unsigned char*)d_ws;
  hipMemsetAsync((unsigned char*)d_ws + OFF_BAR, 0, XCD_BAR_WORDS * sizeof(unsigned), stream);
  void* args[] = {&p};
  hipError_t e = hipLaunchCooperativeKernel((void*)fwd_megakernel, dim3(grid_blocks), dim3(NTHREADS), args, 0, stream);
  if (e != hipSuccess) fprintf(stderr, "cooperative launch failed: %s (grid %d)\n", hipGetErrorString(e), grid_blocks);
}
```
